# Optimizing an MI355X kernel written in HIP

```python
import jax, jax.numpy as jnp
from jax import lax
import numpy as np

D_MODEL = 1024
BATCH = 4
SEQ = 8192
DEPTH = 1

ATT_GROUPS = ((128, 1), (512, 4), (2048, 16))
N_ATT_GROUPS = 3
ATT_HEADS_PER_GROUP = 4
ATT_HEADS = N_ATT_GROUPS * ATT_HEADS_PER_GROUP
ATT_HEAD_DIM = 128
ATT_W = ATT_HEADS * ATT_HEAD_DIM
ATT_OUT_W = ATT_HEADS_PER_GROUP * ATT_HEAD_DIM
ROPE_THETA = 10000.0

RET_HEADS = 4
RET_QK_DIM = 128
RET_V_DIM = 256
RET_QK_W = RET_HEADS * RET_QK_DIM
RET_V_W = RET_HEADS * RET_V_DIM
RET_CHUNK = 128

PEER_HEADS = 8
PEER_N_KEYS = 128
PEER_N_EXPERTS = PEER_N_KEYS * PEER_N_KEYS
PEER_KEY_DIM = 256
PEER_HALF = PEER_KEY_DIM // 2
PEER_TOPK = 16
PEER_TOKEN_BLOCK = 128

NORM_EPS = 1e-6
NEG_INF = -1e30

IN_SPLIT_SIZES = (ATT_W, ATT_W, ATT_W, RET_QK_W, RET_QK_W, RET_V_W, RET_V_W, D_MODEL, D_MODEL)
IN_W = 3 * ATT_W + 2 * RET_QK_W + 2 * RET_V_W + 2 * D_MODEL

kernel_name = "hybrid_dilated_retention_peer_block"


def rms_norm(x, g):
    xf = x.astype(jnp.float32)
    y = xf * lax.rsqrt(jnp.mean(xf * xf, axis=-1, keepdims=True) + NORM_EPS)
    return (y * g.astype(jnp.float32)).astype(x.dtype)


def rope(t, pos):
    hd = t.shape[-1]
    inv = ROPE_THETA ** (-jnp.arange(0, hd, 2, dtype=jnp.float32) / hd)
    ang = pos.astype(jnp.float32)[..., None] * inv
    cos = jnp.cos(ang)[:, :, None, :]
    sin = jnp.sin(ang)[:, :, None, :]
    t1, t2 = jnp.split(t.astype(jnp.float32), 2, axis=-1)
    return jnp.concatenate([t1 * cos - t2 * sin, t1 * sin + t2 * cos], axis=-1).astype(t.dtype)


def dilated_group_attention(q, k, v, window, dilation):
    B, S, H, hd = q.shape
    blk = window // dilation
    span = dilation * blk
    sp = -(-S // span) * span
    pad = sp - S
    L = sp // dilation
    nb = L // blk

    def to_blocks(t):
        t = jnp.pad(t, ((0, 0), (0, pad), (0, 0), (0, 0)))
        t = t.reshape(B, L, dilation, H, hd)
        t = t.transpose(0, 2, 3, 1, 4)
        return t.reshape(B, dilation, H, nb, blk, hd)

    def with_prev(t):
        prev = jnp.pad(t, ((0, 0), (0, 0), (0, 0), (1, 0), (0, 0), (0, 0)))[:, :, :, :-1]
        return jnp.concatenate([prev, t], axis=4)

    qb = to_blocks(q)
    kw = with_prev(to_blocks(k))
    vw = with_prev(to_blocks(v))
    s = jnp.einsum('brhnqd,brhnkd->brhnqk', qb, kw,
                   preferred_element_type=jnp.float32) * (hd ** -0.5)
    qi = jnp.arange(blk)[:, None] + blk
    ki = jnp.arange(2 * blk)[None, :]
    dist = qi - ki
    band = (dist >= 0) & (dist <= blk)
    valid = band[None] & ((jnp.arange(nb)[:, None, None] > 0) | (ki[None] >= blk))
    s = jnp.where(valid, s, NEG_INF)
    m = jnp.max(s, axis=-1, keepdims=True)
    p = jnp.exp(s - m)
    l = jnp.sum(p, axis=-1, keepdims=True)
    o = jnp.einsum('brhnqk,brhnkd->brhnqd', p, vw.astype(jnp.float32)) / l
    lse = (m + jnp.log(l))[..., 0]
    o = o.reshape(B, dilation, H, L, hd).transpose(0, 3, 1, 2, 4).reshape(B, sp, H, hd)[:, :S]
    lse = lse.reshape(B, dilation, H, L).transpose(0, 3, 1, 2).reshape(B, sp, H)[:, :S]
    return o, lse


def retention(q, k, v):
    B, S, H, dk = q.shape
    dv = v.shape[-1]
    C = RET_CHUNK
    nc = S // C
    log_g = jnp.log(1.0 - 2.0 ** (-5.0 - jnp.arange(H, dtype=jnp.float32)))
    qc = q.astype(jnp.float32).reshape(B, nc, C, H, dk)
    kc = k.astype(jnp.float32).reshape(B, nc, C, H, dk)
    vc = v.astype(jnp.float32).reshape(B, nc, C, H, dv)
    idx = jnp.arange(C, dtype=jnp.float32)
    dist = idx[:, None] - idx[None, :]
    decay = jnp.where(dist >= 0, jnp.exp(log_g[:, None, None] * jnp.maximum(dist, 0.0)), 0.0)
    inner = jnp.einsum('bnqhd,bnkhd->bnhqk', qc, kc) * decay
    inner_out = jnp.einsum('bnhqk,bnkhe->bnqhe', inner, vc)
    zeta = jnp.exp(log_g[:, None] * (C - 1.0 - idx))
    kv = jnp.einsum('bnkhd,hk,bnkhe->bnhde', kc, zeta, vc)
    chunk_decay = jnp.exp(log_g * C)[None, :, None, None]

    def step(state, kv_n):
        return state * chunk_decay + kv_n, state

    _, r_prev = lax.scan(step, jnp.zeros((B, H, dk, dv), jnp.float32), kv.transpose(1, 0, 2, 3, 4))
    r_prev = r_prev.transpose(1, 0, 2, 3, 4)
    xi = jnp.exp(log_g[:, None] * (idx + 1.0))
    cross = jnp.einsum('bnqhd,hq,bnhde->bnqhe', qc, xi, r_prev)
    return (inner_out + cross).reshape(B, S, H, dv)


def peer_ffn(h, w_q, keys1, keys2, down, up):
    B, S, D = h.shape
    T = B * S
    x = h.reshape(T, D)
    q = (x @ w_q).reshape(T, PEER_HEADS, 2, PEER_HALF)
    s1 = jnp.einsum('thd,hnd->thn', q[:, :, 0], keys1, preferred_element_type=jnp.float32)
    s2 = jnp.einsum('thd,hnd->thn', q[:, :, 1], keys2, preferred_element_type=jnp.float32)
    v1, i1 = lax.top_k(s1, PEER_TOPK)
    v2, i2 = lax.top_k(s2, PEER_TOPK)
    cand_s = (v1[..., :, None] + v2[..., None, :]).reshape(T, PEER_HEADS, PEER_TOPK * PEER_TOPK)
    cand_id = (i1[..., :, None] * PEER_N_KEYS + i2[..., None, :]).reshape(T, PEER_HEADS, PEER_TOPK * PEER_TOPK)
    top_s, top_pos = lax.top_k(cand_s, PEER_TOPK)
    ids = jnp.take_along_axis(cand_id, top_pos, axis=-1)
    gates = jax.nn.softmax(top_s, axis=-1)
    hk = PEER_HEADS * PEER_TOPK
    nblk = T // PEER_TOKEN_BLOCK

    def expert_block(args):
        xb, idb, gb = args
        a = jnp.einsum('tkd,td->tk', down[idb], xb, preferred_element_type=jnp.float32)
        w = gb * jax.nn.gelu(a, approximate=False)
        return jnp.einsum('tk,tkd->td', w, up[idb].astype(jnp.float32)).astype(xb.dtype)

    out = lax.map(expert_block, (x.reshape(nblk, PEER_TOKEN_BLOCK, D),
                                 ids.reshape(nblk, PEER_TOKEN_BLOCK, hk),
                                 gates.reshape(nblk, PEER_TOKEN_BLOCK, hk)))
    return out.reshape(B, S, D)


def setup_inputs(seed: int = 0) -> dict:
    key = jax.random.key(seed)
    ks = jax.random.split(key, 20)
    D = D_MODEL
    f32 = jnp.float32

    def nrm(k, shape, scale):
        return jax.random.normal(k, shape, f32) * scale

    x = nrm(ks[0], (BATCH, SEQ, D), 1.0)
    c = nrm(ks[1], (BATCH, D), 1.0)
    positions = jnp.broadcast_to(jnp.arange(SEQ, dtype=jnp.int32)[None, :], (BATCH, SEQ))
    return {
        "x": x,
        "c": c,
        "positions": positions,
        "w_ada": nrm(ks[2], (DEPTH, D, 6 * D), 0.5 * D ** -0.5),
        "b_ada": nrm(ks[3], (DEPTH, 6 * D), 0.01),
        "g_pre_mix": 1.0 + nrm(ks[4], (DEPTH, D), 0.02),
        "g_post_mix": 1.0 + nrm(ks[5], (DEPTH, D), 0.02),
        "w_in": nrm(ks[6], (DEPTH, D, IN_W), D ** -0.5),
        "w_att_branch": nrm(ks[7], (DEPTH, ATT_OUT_W, D), ATT_OUT_W ** -0.5),
        "w_ret_branch": nrm(ks[8], (DEPTH, RET_V_W, D), RET_V_W ** -0.5),
        "w_mix_out": nrm(ks[9], (DEPTH, D, D), D ** -0.5),
        "g_pre_ffn": 1.0 + nrm(ks[10], (DEPTH, D), 0.02),
        "g_post_ffn": 1.0 + nrm(ks[11], (DEPTH, D), 0.02),
        "w_peer_q": nrm(ks[12], (DEPTH, D, PEER_HEADS * PEER_KEY_DIM), D ** -0.5),
        "peer_keys1": nrm(ks[13], (DEPTH, PEER_HEADS, PEER_N_KEYS, PEER_HALF), PEER_HALF ** -0.5),
        "peer_keys2": nrm(ks[14], (DEPTH, PEER_HEADS, PEER_N_KEYS, PEER_HALF), PEER_HALF ** -0.5),
        "peer_down": nrm(ks[15], (DEPTH, PEER_N_EXPERTS, D), D ** -0.5),
        "peer_up": nrm(ks[16], (DEPTH, PEER_N_EXPERTS, D), PEER_HEADS ** -0.5),
    }


def reference(x, c, positions, w_ada, b_ada, g_pre_mix, g_post_mix, w_in, w_att_branch,
              w_ret_branch, w_mix_out, g_pre_ffn, g_post_ffn, w_peer_q, peer_keys1,
              peer_keys2, peer_down, peer_up):
    B, S, D = x.shape
    for l in range(DEPTH):
        mod = (jax.nn.silu(c) @ w_ada[l] + b_ada[l])[:, None, :]
        shift1, scale1, gate1, shift2, scale2, gate2 = jnp.split(mod, 6, axis=-1)

        h = rms_norm(x, g_pre_mix[l]) * (1.0 + scale1) + shift1
        cols = []
        off = 0
        for size in IN_SPLIT_SIZES:
            cols.append(h @ w_in[l][:, off:off + size])
            off += size
        aq, ak, av, rq, rk, rv, rg, ga, gr = cols

        aq = rope(aq.reshape(B, S, ATT_HEADS, ATT_HEAD_DIM), positions)
        ak = rope(ak.reshape(B, S, ATT_HEADS, ATT_HEAD_DIM), positions)
        av = av.reshape(B, S, ATT_HEADS, ATT_HEAD_DIM)
        outs, lses = [], []
        for gi, (window, dilation) in enumerate(ATT_GROUPS):
            hs = slice(gi * ATT_HEADS_PER_GROUP, (gi + 1) * ATT_HEADS_PER_GROUP)
            o_g, lse_g = dilated_group_attention(aq[:, :, hs], ak[:, :, hs], av[:, :, hs], window, dilation)
            outs.append(o_g)
            lses.append(lse_g)
        wts = jax.nn.softmax(jnp.stack(lses, axis=0), axis=0)
        y_att = jnp.sum(wts[..., None] * jnp.stack(outs, axis=0), axis=0)
        y_att = y_att.reshape(B, S, ATT_OUT_W).astype(x.dtype) @ w_att_branch[l]

        rq = rope(rq.reshape(B, S, RET_HEADS, RET_QK_DIM), positions)
        rk = rope(rk.reshape(B, S, RET_HEADS, RET_QK_DIM), positions) * (RET_QK_DIM ** -0.5)
        rv = rv.reshape(B, S, RET_HEADS, RET_V_DIM)
        ro = retention(rq, rk, rv)
        ro = ro * lax.rsqrt(jnp.mean(ro * ro, axis=-1, keepdims=True) + NORM_EPS)
        ro = ro * jax.nn.silu(rg.reshape(B, S, RET_HEADS, RET_V_DIM).astype(jnp.float32))
        y_ret = ro.reshape(B, S, RET_V_W).astype(x.dtype) @ w_ret_branch[l]

        y = jax.nn.sigmoid(ga) * y_att + jax.nn.sigmoid(gr) * y_ret
        y = y @ w_mix_out[l]
        x = x + gate1 * rms_norm(y, g_post_mix[l])

        h2 = rms_norm(x, g_pre_ffn[l]) * (1.0 + scale2) + shift2
        f = peer_ffn(h2, w_peer_q[l], peer_keys1[l], peer_keys2[l], peer_down[l], peer_up[l])
        x = x + gate2 * rms_norm(f, g_post_ffn[l])
    return x
```

```cpp
#define MULTI_LAUNCH 1
#include <hip/hip_runtime.h>
#include <hip/hip_cooperative_groups.h>
#include <cstdio>
namespace cg = cooperative_groups;

#define LAS __attribute__((address_space(3)))
typedef unsigned short bf16_t;
typedef short bf16x8 __attribute__((ext_vector_type(8)));
typedef short s16x4 __attribute__((ext_vector_type(4)));
typedef float f32x4 __attribute__((ext_vector_type(4)));
typedef float f32x2 __attribute__((ext_vector_type(2)));
typedef unsigned u32x4 __attribute__((ext_vector_type(4)));
typedef unsigned u32x2 __attribute__((ext_vector_type(2)));

constexpr int NB = 4, SEQ = 8192, T = NB * SEQ, DM = 1024;
constexpr int ATT_W = 1536, RET_QK_W = 512, RET_V_W = 1024, IN_W = 9728;
constexpr int NA = 4608;
constexpr int NBC = 5120;
constexpr float NORM_EPS = 1e-6f;
constexpr size_t MiB = 1ull << 20;

constexpr size_t WS_CTL   = 0;
constexpr size_t WS_MOD   = 65536;
constexpr size_t WS_WIN_T = 1 * MiB;
constexpr size_t WS_WA_T  = 20 * MiB;
constexpr size_t WS_WR_T  = 21 * MiB;
constexpr size_t WS_WMX_T = 23 * MiB;
constexpr size_t WS_WPQ_T = 25 * MiB;
constexpr size_t WS_KEYS  = 29 * MiB;
constexpr size_t WS_ROPE  = 30 * MiB;
constexpr size_t WS_R1    = 48 * MiB;
constexpr size_t WS_AQ = WS_R1, WS_AK = WS_R1 + 96 * MiB, WS_AV = WS_R1 + 192 * MiB;
constexpr size_t WS_RQ = WS_R1, WS_RK = WS_R1 + 32 * MiB, WS_RV = WS_R1 + 64 * MiB, WS_RG = WS_R1 + 128 * MiB, WS_GA = WS_R1 + 192 * MiB;
constexpr size_t WS_KV = 304 * MiB;
constexpr size_t WS_RO = 304 * MiB;
constexpr size_t WS_OG = 336 * MiB;
constexpr size_t WS_LSE = 432 * MiB;
constexpr size_t WS_GR = 434 * MiB;
constexpr size_t WS_Y1 = WS_R1;
constexpr size_t WS_Y  = WS_R1 + 64 * MiB;
constexpr size_t WS_YM = WS_R1 + 128 * MiB;
constexpr size_t WS_H2 = WS_R1;
constexpr size_t WS_DN = 304 * MiB;
constexpr size_t WS_UP = 368 * MiB;
constexpr size_t WS_QP = WS_R1 + 64 * MiB;
constexpr size_t WS_IDS = 240 * MiB;
constexpr size_t WS_GT  = 256 * MiB;
constexpr size_t WS_END = 498 * MiB;
constexpr size_t DO_H = 0, DO_YATT = 64 * MiB, DO_RPREV = 0;

constexpr int LDS_BYTES = 143360;

struct Params {
    const float* x; const float* c; const int* pos; const float* w_ada; const float* b_ada; const float* g_pre_mix; const float* g_post_mix; const float* w_in;
    const float* w_att; const float* w_ret; const float* w_mix; const float* g_pre_ffn; const float* g_post_ffn; const float* w_pq; const float* keys1; const float* keys2;
    const float* down; const float* up; float* out; unsigned char* ws; long long ph_lo, ph_hi;
};

__device__ __forceinline__ unsigned cvt_pk_bf16(float lo, float hi) { unsigned r; asm("v_cvt_pk_bf16_f32 %0, %1, %2" : "=v"(r) : "v"(lo), "v"(hi)); return r; }
__device__ __forceinline__ float bf_lo(unsigned u) { return __uint_as_float(u << 16); }
__device__ __forceinline__ float bf_hi(unsigned u) { return __uint_as_float(u & 0xffff0000u); }
__device__ __forceinline__ float wave_sum(float v) {
#pragma unroll
    for (int o = 32; o >= 1; o >>= 1) v += __shfl_xor(v, o);
    return v;
}
__device__ __forceinline__ float fast_exp2(float x) { return __builtin_amdgcn_exp2f(x); }
__device__ __forceinline__ float sigmoidf_(float x) { return 1.0f / (1.0f + __expf(-x)); }
__device__ __forceinline__ int rope_logical(int nphys) { const int p = nphys & 127; return (nphys & ~127) + 64 * ((p >> 4) & 1) + 16 * (p >> 5) + (p & 15); }
__device__ __forceinline__ s16x4 lds_tr(const LAS unsigned char* a) { return __builtin_amdgcn_ds_read_tr16_b64_v4i16((LAS s16x4*)a); }
__device__ __forceinline__ bf16x8 cat8(s16x4 lo, s16x4 hi) { return (bf16x8){lo[0], lo[1], lo[2], lo[3], hi[0], hi[1], hi[2], hi[3]}; }
namespace pg8 {
constexpr int BM = 256, BK = 64, HALF = 128, HTB = HALF * BK * 2  , STAGE_BYTES = 8 * HTB, NXCD = 8, WGM = 8;

__host__ __device__ __forceinline__ int lds_byte(int r, int c) { const int st = (r >> 4) * 2 + (c >> 5), rr = r & 15, cc = c & 31, ob = rr * 64 + cc * 2; return st * 1024 + (ob ^ (((ob >> 9) & 1) << 5)); }
__host__ __device__ __forceinline__ void stage_rc(int b, int& R, int& C) { const int st = b / 1024, sb = b % 1024, swz = sb ^ (((sb >> 9) & 1) << 5); R = (st >> 1) * 16 + swz / 64; C = (st & 1) * 32 + (swz % 64) / 2; }
__host__ __device__ __forceinline__ int perm32(int rho) { const int n = rho >> 4, i = rho & 15; return 8 * (i >> 2) + 4 * n + (i & 3); }

struct Unit { int pm, pn; };
struct Gemm { const bf16_t* A; const bf16_t* Bt; int M, N, K; };

struct StaticOrder {
    int nM, nN, nwg, G, c;
    __host__ __device__ void init(int M, int N, int G_, int c_) { nM = M / BM; nN = N / BM; nwg = nM * nN; G = G_; c = c_; }
    __host__ __device__ bool next(int i, Unit& u) const {
        const long L = (long)i * G + c; if (L >= nwg) return false;
        int wgid = (int)L; { const int q = nwg / NXCD, r = nwg % NXCD, xcd = wgid % NXCD, off = wgid / NXCD; wgid = (xcd < r ? xcd * (q + 1) : r * (q + 1) + (xcd - r) * q) + off; }
        const int nig = WGM * nN, gid = wgid / nig, fm = gid * WGM, gsz = (nM - fm) < WGM ? (nM - fm) : WGM;
        u.pm = fm + ((wgid % nig) % gsz); u.pn = (wgid % nig) / gsz; return true;
    }
    __device__ __forceinline__ void a_ready(const Unit&) const {}
    __device__ __forceinline__ void done(const Unit&) const {}
};

template <class Epi, class Sched>
__device__ __forceinline__ void gemm_phase(LAS unsigned char* lds, const Gemm g, const Sched& S, const Epi& E) {
    const int tid = threadIdx.x, wid = __builtin_amdgcn_readfirstlane(tid >> 6), lane = tid & 63, wr = wid >> 2, wc = wid & 3, fr = lane & 15, fq = lane >> 4;
    const int K = g.K, nt = K / BK;
    unsigned voffA[2], voffB[2];
#pragma unroll
    for (int i = 0; i < 2; ++i) { int R, C; stage_rc(tid * 16 + i * 8192, R, C); const int Rb = Epi::PERM ? ((R & ~31) + perm32(R & 31)) : R;
        voffA[i] = (unsigned)(R * K + C) * 2u; voffB[i] = (unsigned)(Rb * K + C) * 2u; }
    const size_t kstep = (size_t)(BK * 2);
    const size_t hstep = (size_t)HALF * K * 2;
    const size_t tstep = 2 * hstep;
    const unsigned ldsw = (unsigned)wid * 1024u;
    const int aoff = lds_byte(wr * 64 + fr, fq * 8), boff = lds_byte(wc * 32 + fr, fq * 8);
#define PG8_SA(b, h) (((b) * 2 + (h)) * HTB)
#define PG8_SB(b, h) ((4 + (b) * 2 + (h)) * HTB)
#define PG8_STAGE(bufoff, gbase, voff) do { _Pragma("unroll") for (int _i = 0; _i < 2; ++_i) \
        __builtin_amdgcn_global_load_lds((const unsigned*)((const char*)(gbase) + (voff)[_i]), (LAS unsigned*)(lds + (bufoff) + ldsw + _i * 8192), 16, 0, 0); } while (0)
#define PG8_LDA(dst, b, h) do { _Pragma("unroll") for (int m = 0; m < 4; ++m) _Pragma("unroll") for (int k = 0; k < 2; ++k) dst[m][k] = *(const LAS bf16x8*)(lds + PG8_SA(b, h) + aoff + m * 2048 + k * 1024); } while (0)
#define PG8_LDB(dst, b, h) do { _Pragma("unroll") for (int n = 0; n < 2; ++n) _Pragma("unroll") for (int k = 0; k < 2; ++k) dst[n][k] = *(const LAS bf16x8*)(lds + PG8_SB(b, h) + boff + n * 2048 + k * 1024); } while (0)
#define PG8_MMA(ai, bj, At, Bt) do { __builtin_amdgcn_s_setprio(1); _Pragma("unroll") for (int m = 0; m < 4; ++m) _Pragma("unroll") for (int n = 0; n < 2; ++n) _Pragma("unroll") for (int k = 0; k < 2; ++k) \
        acc[ai][bj][m][n] = __builtin_amdgcn_mfma_f32_16x16x32_bf16(Bt[n][k], At[m][k], acc[ai][bj][m][n], 0, 0, 0); __builtin_amdgcn_s_setprio(0); } while (0)
#define PG8_WAIT_V(n) asm volatile("s_waitcnt vmcnt(" #n ")" ::: "memory")
#define PG8_WAIT_L(n) asm volatile("s_waitcnt lgkmcnt(" #n ")" ::: "memory")
#define PG8_BAR __builtin_amdgcn_s_barrier()
#define PG8_SCHED __builtin_amdgcn_sched_barrier(0)
    Unit cur, nxt; int ui = 0;
    if (!S.next(0, cur)) return;
    f32x4 acc[2][2][4][2];
#pragma unroll
    for (int a = 0; a < 2; ++a)
#pragma unroll
        for (int b = 0; b < 2; ++b)
#pragma unroll
            for (int m = 0; m < 4; ++m)
#pragma unroll
                for (int n = 0; n < 2; ++n) acc[a][b][m][n] = (f32x4){0.f, 0.f, 0.f, 0.f};
    bf16x8 At[4][2], B0[2][2], B1[2][2];
    const char* cA = (const char*)g.A + (size_t)cur.pm * tstep; const char* cB = (const char*)g.Bt + (size_t)cur.pn * tstep;
    S.a_ready(cur);
    PG8_STAGE(PG8_SB(0, 0), cB, voffB); PG8_STAGE(PG8_SA(0, 0), cA, voffA); PG8_STAGE(PG8_SB(0, 1), cB + hstep, voffB); PG8_STAGE(PG8_SA(0, 1), cA + hstep, voffA);
    if (wr == 1) PG8_BAR;
    PG8_WAIT_V(4); PG8_BAR;
    PG8_STAGE(PG8_SB(1, 0), cB + kstep, voffB); PG8_STAGE(PG8_SA(1, 0), cA + kstep, voffA); PG8_STAGE(PG8_SB(1, 1), cB + hstep + kstep, voffB);
    PG8_WAIT_V(6); PG8_BAR;
    for (;;) {
        const bool has_next = S.next(ui + 1, nxt);
        const char* nA = has_next ? (const char*)g.A + (size_t)nxt.pm * tstep : cA; const char* nB = has_next ? (const char*)g.Bt + (size_t)nxt.pn * tstep : cB;
        for (int t = 0; t < nt; t += 2) {
            const bool last = (t == nt - 2);
            const char* a1 = cA + (size_t)(t + 1) * kstep;
            const char* a2 = last ? nA : cA + (size_t)(t + 2) * kstep; const char* b2 = last ? nB : cB + (size_t)(t + 2) * kstep;
            const char* a3 = a2 + kstep; const char* b3 = b2 + kstep;
            if (last && has_next) S.a_ready(nxt);
            PG8_LDB(B0, 0, 0); PG8_SCHED; PG8_LDA(At, 0, 0); PG8_STAGE(PG8_SA(1, 1), a1 + hstep, voffA);
            PG8_WAIT_L(8); PG8_BAR; PG8_WAIT_L(0); PG8_MMA(0, 0, At, B0); PG8_BAR; PG8_SCHED;
            PG8_LDB(B1, 0, 1); PG8_STAGE(PG8_SB(0, 0), b2, voffB);
            PG8_BAR; PG8_WAIT_L(0); PG8_MMA(0, 1, At, B1); PG8_BAR;
            PG8_LDA(At, 0, 1); PG8_STAGE(PG8_SA(0, 0), a2, voffA);
            PG8_BAR; PG8_WAIT_L(0); PG8_MMA(1, 0, At, B0); PG8_BAR; PG8_SCHED;
            PG8_STAGE(PG8_SB(0, 1), b2 + hstep, voffB);
            PG8_WAIT_V(6); PG8_BAR; PG8_MMA(1, 1, At, B1); PG8_BAR;
            PG8_LDB(B0, 1, 0); PG8_SCHED; PG8_LDA(At, 1, 0); PG8_STAGE(PG8_SA(0, 1), a2 + hstep, voffA);
            PG8_WAIT_L(8); PG8_BAR; PG8_WAIT_L(0); PG8_MMA(0, 0, At, B0); PG8_BAR; PG8_SCHED;
            PG8_LDB(B1, 1, 1); PG8_STAGE(PG8_SB(1, 0), b3, voffB);
            PG8_BAR; PG8_WAIT_L(0); PG8_MMA(0, 1, At, B1); PG8_BAR;
            PG8_LDA(At, 1, 1); PG8_STAGE(PG8_SA(1, 0), a3, voffA);
            PG8_BAR; PG8_WAIT_L(0); PG8_MMA(1, 0, At, B0); PG8_BAR; PG8_SCHED;
            PG8_STAGE(PG8_SB(1, 1), b3 + hstep, voffB);
            PG8_WAIT_V(6); PG8_BAR; PG8_MMA(1, 1, At, B1); PG8_BAR;
        }
        if constexpr (!Epi::AFTER_DRAIN) { E(acc, cur, wr, wc, fr, fq); S.done(cur); }
        if (!has_next) break;
#pragma unroll
        for (int a = 0; a < 2; ++a)
#pragma unroll
            for (int b = 0; b < 2; ++b)
#pragma unroll
                for (int m = 0; m < 4; ++m)
#pragma unroll
                    for (int n = 0; n < 2; ++n) acc[a][b][m][n] = (f32x4){0.f, 0.f, 0.f, 0.f};
        cur = nxt; cA = nA; cB = nB; ++ui;
    }
    PG8_WAIT_V(0);
    if (wr == 0) PG8_BAR;
    PG8_BAR;
    if constexpr (Epi::AFTER_DRAIN) { E.fused(acc, cur, wr, wc, fr, fq, lds, wid, lane); S.done(cur); }
#undef PG8_SA
#undef PG8_SB
#undef PG8_STAGE
#undef PG8_LDA
#undef PG8_LDB
#undef PG8_MMA
#undef PG8_WAIT_V
#undef PG8_WAIT_L
#undef PG8_BAR
#undef PG8_SCHED
}
}


enum { EK_A = 0, EK_B = 1, EK_C = 2, EK_D = 3, EK_E = 4, EK_F = 5 };
struct EpiGen {
    static constexpr bool PERM = false, AFTER_DRAIN = false;
    int kind; unsigned char* ws; unsigned char* dout;
    __device__ __forceinline__ void operator()(const f32x4 (&acc)[2][2][4][2], const pg8::Unit& u, int wr, int wc, int fr, int fq) const {
        int mode = 0, ld = 1024, colbase = 0; size_t dsto = 0; float sc = 1.0f;
        const int pn = u.pn;
        if (kind == EK_A) { const int tq = pn / 6; colbase = (pn - tq * 6) * 256; ld = ATT_W; dsto = WS_AQ + (size_t)tq * 96 * MiB; mode = tq < 2 ? 1 : 0; sc = tq == 0 ? 0.08838834764831845f * 1.4426950408889634f : 1.0f; }
        else if (kind == EK_B) {
            if (pn < 2)       { mode = 1; ld = RET_QK_W; colbase = pn * 256; dsto = WS_RQ; }
            else if (pn < 4)  { mode = 1; ld = RET_QK_W; colbase = (pn - 2) * 256; dsto = WS_RK; sc = 0.08838834764831845f; }
            else if (pn < 8)  { mode = 0; colbase = (pn - 4) * 256; dsto = WS_RV; }
            else if (pn < 12) { mode = 2; colbase = (pn - 8) * 256; dsto = WS_RG; }
            else if (pn < 16) { mode = 3; colbase = (pn - 12) * 256; dsto = WS_GA; }
            else              { mode = 3; colbase = (pn - 16) * 256; dsto = WS_GR; }
        }
        else if (kind == EK_C) { mode = 4; colbase = pn * 256; dsto = WS_Y1; }
        else if (kind == EK_D) { mode = 5; colbase = pn * 256; dsto = WS_Y; }
        else if (kind == EK_E) { mode = 6; colbase = pn * 256; dsto = WS_YM; }
        else                   { mode = 0; ld = 2048; colbase = pn * 256; dsto = WS_QP; }
        const int row0 = u.pm * 256 + wr * 64 + fr;
        if (mode == 1) {
            bf16_t* dst = (bf16_t*)(ws + dsto);
            const float* rope = (const float*)(ws + WS_ROPE);
            const int d0 = 16 * wc + 4 * fq;
#pragma unroll
            for (int ai = 0; ai < 2; ++ai)
#pragma unroll
                for (int m = 0; m < 4; ++m) {
                    const int row = row0 + ai * 128 + m * 16;
                    const f32x4 cs0 = *(const f32x4*)(rope + ((size_t)row * 64 + d0) * 2), cs1 = *(const f32x4*)(rope + ((size_t)row * 64 + d0) * 2 + 4);
                    const float cc[4] = {cs0[0], cs0[2], cs1[0], cs1[2]}, ss[4] = {cs0[1], cs0[3], cs1[1], cs1[3]};
#pragma unroll
                    for (int bj = 0; bj < 2; ++bj) {
                        const f32x4 x1 = acc[ai][bj][m][0], x2 = acc[ai][bj][m][1];
                        float o1[4], o2[4];
#pragma unroll
                        for (int i = 0; i < 4; ++i) { o1[i] = (x1[i] * cc[i] - x2[i] * ss[i]) * sc; o2[i] = (x1[i] * ss[i] + x2[i] * cc[i]) * sc; }
                        bf16_t* rp = dst + (size_t)row * ld + colbase + bj * 128 + d0;
                        u32x2 w1, w2; w1.x = cvt_pk_bf16(o1[0], o1[1]); w1.y = cvt_pk_bf16(o1[2], o1[3]); w2.x = cvt_pk_bf16(o2[0], o2[1]); w2.y = cvt_pk_bf16(o2[2], o2[3]);
                        *(u32x2*)rp = w1; *(u32x2*)(rp + 64) = w2;
                    }
                }
        } else if (mode == 6) {
            float* dst = (float*)(ws + dsto);
#pragma unroll
            for (int ai = 0; ai < 2; ++ai)
#pragma unroll
                for (int m = 0; m < 4; ++m) {
                    float* rp = dst + (size_t)(row0 + ai * 128 + m * 16) * ld + colbase + wc * 32 + 4 * fq;
#pragma unroll
                    for (int bj = 0; bj < 2; ++bj)
#pragma unroll
                        for (int n = 0; n < 2; ++n) *(f32x4*)(rp + bj * 128 + n * 16) = acc[ai][bj][m][n];
                }
        } else {
            bf16_t* dst = (bf16_t*)(ws + dsto);
            const bf16_t* gate = (const bf16_t*)(ws + (mode == 4 ? WS_GA : WS_GR));
            const bf16_t* y1 = (const bf16_t*)(ws + WS_Y1);
#pragma unroll
            for (int ai = 0; ai < 2; ++ai)
#pragma unroll
                for (int m = 0; m < 4; ++m) {
                    const size_t ro = (size_t)(row0 + ai * 128 + m * 16) * ld + colbase + wc * 32 + 4 * fq;
#pragma unroll
                    for (int bj = 0; bj < 2; ++bj)
#pragma unroll
                        for (int n = 0; n < 2; ++n) {
                            f32x4 v = acc[ai][bj][m][n];
                            const size_t o = ro + bj * 128 + n * 16;
                            if (mode == 2) {
#pragma unroll
                                for (int i = 0; i < 4; ++i) v[i] = v[i] * sigmoidf_(v[i]);
                            } else if (mode == 3) {
#pragma unroll
                                for (int i = 0; i < 4; ++i) v[i] = sigmoidf_(v[i]);
                            } else if (mode >= 4) {
                                const u32x2 gq = *(const u32x2*)(gate + o);
                                v[0] *= bf_lo(gq.x); v[1] *= bf_hi(gq.x); v[2] *= bf_lo(gq.y); v[3] *= bf_hi(gq.y);
                                if (mode == 5) { const u32x2 yq = *(const u32x2*)(y1 + o); v[0] += bf_lo(yq.x); v[1] += bf_hi(yq.x); v[2] += bf_lo(yq.y); v[3] += bf_hi(yq.y); }
                            }
                            u32x2 w; w.x = cvt_pk_bf16(v[0], v[1]); w.y = cvt_pk_bf16(v[2], v[3]);
                            *(u32x2*)(dst + o) = w;
                        }
                }
        }
    }
};

__device__ __forceinline__ void transpose_tile(const float* __restrict__ W, int K, int N, bf16_t* __restrict__ Wt, int k0, int n0, bool ropeperm, LAS float* tile, const int tid0) {
    const int tid = tid0;
#pragma unroll
    for (int i = 0; i < 8; ++i) { const int idx = tid + 512 * i, r = idx >> 6, c = idx & 63; const int nphys = n0 + c, nlog = ropeperm ? rope_logical(nphys) : nphys;
        tile[r * 65 + c] = W[(size_t)(k0 + r) * N + nlog]; }
    __syncthreads();
#pragma unroll
    for (int i = 0; i < 4; ++i) { const int idx = tid + 512 * i, nn = idx >> 5, kk = (idx & 31) * 2;
        *(unsigned*)(Wt + (size_t)(n0 + nn) * K + k0 + kk) = cvt_pk_bf16(tile[kk * 65 + nn], tile[(kk + 1) * 65 + nn]); }
    __syncthreads();
}

__device__ __forceinline__ void phase_prep(const Params& p, LAS unsigned char* lds, const int tid0) {
    const int tid = tid0;
    LAS float* fl = (LAS float*)lds;
    constexpr int N_MOD = 96, N_TW = 16 * 152, N_TA = 8 * 16, N_TR = 16 * 16, N_TM = 16 * 16, N_TP = 16 * 32, N_KEY = 64, N_ROPE = 1024;
    constexpr int O_TW = N_MOD, O_TA = O_TW + N_TW, O_TR = O_TA + N_TA, O_TM = O_TR + N_TR, O_TP = O_TM + N_TM, O_KEY = O_TP + N_TP, O_ROPE = O_KEY + N_KEY, N_ALL = O_ROPE + N_ROPE;
    for (int item = blockIdx.x; item < N_ALL; item += gridDim.x) {
        if (item < O_TW) {
            LAS float* sc = fl;
            LAS float* red = fl + 4096;
            for (int i = tid; i < 4096; i += 512) { const float v = p.c[i]; sc[i] = v * sigmoidf_(v); }
            __syncthreads();
            const int col = item * 64 + (tid & 63), kg = tid >> 6;
            float a0 = 0.f, a1 = 0.f, a2 = 0.f, a3 = 0.f;
#pragma unroll 8
            for (int k = kg * 128; k < kg * 128 + 128; ++k) { const float w = p.w_ada[(size_t)k * 6144 + col]; a0 += sc[k] * w; a1 += sc[1024 + k] * w; a2 += sc[2048 + k] * w; a3 += sc[3072 + k] * w; }
            red[(kg * 4 + 0) * 64 + (tid & 63)] = a0; red[(kg * 4 + 1) * 64 + (tid & 63)] = a1; red[(kg * 4 + 2) * 64 + (tid & 63)] = a2; red[(kg * 4 + 3) * 64 + (tid & 63)] = a3;
            __syncthreads();
            if (tid < 256) { const int b = tid >> 6, cc = tid & 63; float s = 0.f;
#pragma unroll
                for (int g = 0; g < 8; ++g) s += red[(g * 4 + b) * 64 + cc];
                ((float*)(p.ws + WS_MOD))[b * 6144 + item * 64 + cc] = s + p.b_ada[item * 64 + cc]; }
            __syncthreads();
        } else if (item < O_TA) { const int t = item - O_TW, kt = t & 15, nt = t >> 4; const int n0 = nt * 64; const bool rp = (n0 < 3072) || (n0 >= 4608 && n0 < 5632);
            transpose_tile(p.w_in, 1024, IN_W, (bf16_t*)(p.ws + WS_WIN_T), kt * 64, n0, rp, fl, tid0);
        } else if (item < O_TR) { const int t = item - O_TA, kt = t & 7, nt = t >> 3; transpose_tile(p.w_att, 512, 1024, (bf16_t*)(p.ws + WS_WA_T), kt * 64, nt * 64, false, fl, tid0);
        } else if (item < O_TM) { const int t = item - O_TR, kt = t & 15, nt = t >> 4; transpose_tile(p.w_ret, 1024, 1024, (bf16_t*)(p.ws + WS_WR_T), kt * 64, nt * 64, false, fl, tid0);
        } else if (item < O_TP) { const int t = item - O_TM, kt = t & 15, nt = t >> 4; transpose_tile(p.w_mix, 1024, 1024, (bf16_t*)(p.ws + WS_WMX_T), kt * 64, nt * 64, false, fl, tid0);
        } else if (item < O_KEY) { const int t = item - O_TP, kt = t & 15, nt = t >> 4; transpose_tile(p.w_pq, 1024, 2048, (bf16_t*)(p.ws + WS_WPQ_T), kt * 64, nt * 64, false, fl, tid0);
        } else if (item < O_ROPE) { const int t = item - O_KEY;
            const float* src = t < 32 ? p.keys1 : p.keys2; const int base = (t & 31) * 4096 + tid * 8;
            const f32x4 a = *(const f32x4*)(src + base), b = *(const f32x4*)(src + base + 4);
            u32x4 w; w.x = cvt_pk_bf16(a[0], a[1]); w.y = cvt_pk_bf16(a[2], a[3]); w.z = cvt_pk_bf16(b[0], b[1]); w.w = cvt_pk_bf16(b[2], b[3]);
            *(u32x4*)((bf16_t*)(p.ws + WS_KEYS) + (size_t)(t >> 5) * 131072 + base) = w;
        } else { const int t = item - O_ROPE;
            float* rope = (float*)(p.ws + WS_ROPE);
#pragma unroll
            for (int i = 0; i < 4; ++i) { const int e = t * 2048 + i * 512 + tid, tok = e >> 6, dd = e & 63;
                const double inv = exp2(-(double)dd * (13.287712379549449 / 64.0));
                double rev = (double)p.pos[tok] * inv * 0.15915494309189535; rev -= rint(rev);
                const float rf = (float)rev;
                f32x2 cs; cs.x = __builtin_amdgcn_cosf(rf); cs.y = __builtin_amdgcn_sinf(rf);
                *(f32x2*)(rope + (size_t)e * 2) = cs; }
        }
    }
}

__device__ __forceinline__ void phase_h(const Params& p, const int tid0) {
    const int lane = tid0 & 63, w = tid0 >> 6;
    const float* mod = (const float*)(p.ws + WS_MOD);
    bf16_t* h = (bf16_t*)((unsigned char*)p.out + DO_H);
    for (int row = blockIdx.x * 8 + w; row < T; row += gridDim.x * 8) {
        const int b = row / SEQ;
        f32x4 v[4]; float ss = 0.f;
#pragma unroll
        for (int i = 0; i < 4; ++i) { v[i] = *(const f32x4*)(p.x + (size_t)row * DM + i * 256 + lane * 4); ss += v[i][0] * v[i][0] + v[i][1] * v[i][1] + v[i][2] * v[i][2] + v[i][3] * v[i][3]; }
        ss = wave_sum(ss);
        const float rstd = rsqrtf(ss * (1.0f / DM) + NORM_EPS);
#pragma unroll
        for (int i = 0; i < 4; ++i) { const int c = i * 256 + lane * 4;
            const f32x4 g = *(const f32x4*)(p.g_pre_mix + c), sh = *(const f32x4*)(mod + b * 6144 + c), sc = *(const f32x4*)(mod + b * 6144 + 1024 + c);
            float o[4];
#pragma unroll
            for (int j = 0; j < 4; ++j) o[j] = v[i][j] * rstd * g[j] * (1.0f + sc[j]) + sh[j];
            u32x2 wv; wv.x = cvt_pk_bf16(o[0], o[1]); wv.y = cvt_pk_bf16(o[2], o[3]);
            *(u32x2*)(h + (size_t)row * DM + c) = wv; }
    }
}

__device__ __forceinline__ void phase_attn(const Params& p, LAS unsigned char* lds, const int tid0) {
    const int tid = tid0, lane = tid & 63, w = tid >> 6, l15 = lane & 15, g4 = lane >> 4;
    LAS unsigned char* Ks = lds;
    LAS unsigned char* Vs = lds + 256 * 272;
    const bf16_t* aq = (const bf16_t*)(p.ws + WS_AQ); const bf16_t* ak = (const bf16_t*)(p.ws + WS_AK); const bf16_t* av = (const bf16_t*)(p.ws + WS_AV);
    bf16_t* og = (bf16_t*)(p.ws + WS_OG); float* lse = (float*)(p.ws + WS_LSE);
    for (int item = blockIdx.x; item < 3072; item += gridDim.x) {
        const int b = item / 768, rem = item - b * 768, h12 = rem >> 6, qb = rem & 63, grp = h12 >> 2, hh = h12 & 3;
        const int dsh = grp * 2, dil = 1 << dsh, r = qb & (dil - 1), n = qb >> dsh;
        const size_t tb = (size_t)b * SEQ;
#pragma unroll
        for (int it = 0; it < 8; ++it) { const int c = tid + 512 * it, row = c >> 4, ch = c & 15; const int m = 128 * (n - 1) + row;
            u32x4 kv = {0u, 0u, 0u, 0u}, vv = {0u, 0u, 0u, 0u};
            if (m >= 0) { const size_t off = (tb + (size_t)m * dil + r) * ATT_W + h12 * 128 + ch * 8; kv = *(const u32x4*)(ak + off); vv = *(const u32x4*)(av + off); }
            *(LAS u32x4*)(Ks + row * 272 + ch * 16) = kv; *(LAS u32x4*)(Vs + row * 288 + ch * 16) = vv; }
        const int i = 16 * w + l15;
        const size_t tq = tb + (size_t)(128 * n + i) * dil + r;
        bf16x8 qf[4];
#pragma unroll
        for (int kk = 0; kk < 4; ++kk) qf[kk] = *(const bf16x8*)(aq + tq * ATT_W + h12 * 128 + 32 * kk + 8 * g4);
        __syncthreads();
        const int kt0 = w < 6 ? w : 6;
        f32x4 sacc[10];
#pragma unroll
        for (int t = 0; t < 10; ++t) { f32x4 a4 = {0.f, 0.f, 0.f, 0.f};
#pragma unroll
            for (int kk = 0; kk < 4; ++kk) { const bf16x8 kf = *(const LAS bf16x8*)(Ks + (16 * (kt0 + t) + l15) * 272 + (32 * kk + 8 * g4) * 2); a4 = __builtin_amdgcn_mfma_f32_16x16x32_bf16(kf, qf[kk], a4, 0, 0, 0); }
            sacc[t] = a4; }
        float mx = -1e30f;
#pragma unroll
        for (int t = 0; t < 10; ++t)
#pragma unroll
            for (int rg = 0; rg < 4; ++rg) { const int jj = 16 * (kt0 + t) + 4 * g4 + rg; const bool valid = (jj >= i) && (jj <= i + 128) && (n > 0 || jj >= 128);
                const float s = valid ? sacc[t][rg] : -1e30f; sacc[t][rg] = s; mx = fmaxf(mx, s); }
        mx = fmaxf(mx, __shfl_xor(mx, 16)); mx = fmaxf(mx, __shfl_xor(mx, 32));
        float sum = 0.f;
#pragma unroll
        for (int t = 0; t < 10; ++t)
#pragma unroll
            for (int rg = 0; rg < 4; ++rg) { const float e = fast_exp2(sacc[t][rg] - mx); sacc[t][rg] = e; sum += e; }
        sum += __shfl_xor(sum, 16); sum += __shfl_xor(sum, 32);
        f32x4 oacc[8];
#pragma unroll
        for (int et = 0; et < 8; ++et) oacc[et] = (f32x4){0.f, 0.f, 0.f, 0.f};
#pragma unroll
        for (int s5 = 0; s5 < 5; ++s5) {
            u32x4 pw; pw.x = cvt_pk_bf16(sacc[2 * s5][0], sacc[2 * s5][1]); pw.y = cvt_pk_bf16(sacc[2 * s5][2], sacc[2 * s5][3]);
            pw.z = cvt_pk_bf16(sacc[2 * s5 + 1][0], sacc[2 * s5 + 1][1]); pw.w = cvt_pk_bf16(sacc[2 * s5 + 1][2], sacc[2 * s5 + 1][3]);
            const bf16x8 pf = __builtin_bit_cast(bf16x8, pw);
            const LAS unsigned char* vb = Vs + (16 * (kt0 + 2 * s5) + 4 * g4 + (l15 >> 2)) * 288 + (4 * (l15 & 3)) * 2;
#pragma unroll
            for (int et = 0; et < 8; ++et) { const s16x4 lo = lds_tr(vb + et * 32), hi = lds_tr(vb + et * 32 + 16 * 288);
                oacc[et] = __builtin_amdgcn_mfma_f32_16x16x32_bf16(cat8(lo, hi), pf, oacc[et], 0, 0, 0); }
        }
        const float inv = 1.0f / sum;
        bf16_t* op = og + (size_t)grp * T * 512 + tq * 512 + hh * 128 + 4 * g4;
#pragma unroll
        for (int et = 0; et < 8; ++et) { u32x2 wv; wv.x = cvt_pk_bf16(oacc[et][0] * inv, oacc[et][1] * inv); wv.y = cvt_pk_bf16(oacc[et][2] * inv, oacc[et][3] * inv); *(u32x2*)(op + et * 16) = wv; }
        if (g4 == 0) lse[(size_t)grp * T * 4 + tq * 4 + hh] = mx * 0.6931471805599453f + __logf(sum);
        __syncthreads();
    }
}

__device__ __forceinline__ void phase_combine(const Params& p, const int tid0) {
    const bf16_t* og = (const bf16_t*)(p.ws + WS_OG); const float* lse = (const float*)(p.ws + WS_LSE);
    bf16_t* ya = (bf16_t*)((unsigned char*)p.out + DO_YATT);
    for (int idx = blockIdx.x * 512 + tid0; idx < T * 64; idx += gridDim.x * 512) {
        const int t = idx >> 6, c8 = idx & 63, hh = c8 >> 4;
        const float l0 = lse[(size_t)t * 4 + hh], l1 = lse[(size_t)T * 4 + (size_t)t * 4 + hh], l2 = lse[(size_t)T * 8 + (size_t)t * 4 + hh];
        const float m = fmaxf(l0, fmaxf(l1, l2)); float w0 = __expf(l0 - m), w1 = __expf(l1 - m), w2 = __expf(l2 - m); const float iv = 1.0f / (w0 + w1 + w2); w0 *= iv; w1 *= iv; w2 *= iv;
        const size_t o = (size_t)t * 512 + c8 * 8;
        const u32x4 a = *(const u32x4*)(og + o), bq = *(const u32x4*)(og + (size_t)T * 512 + o), cq = *(const u32x4*)(og + (size_t)T * 1024 + o);
        u32x4 r;
#pragma unroll
        for (int j = 0; j < 4; ++j) { const float lo = w0 * bf_lo(a[j]) + w1 * bf_lo(bq[j]) + w2 * bf_lo(cq[j]), hi = w0 * bf_hi(a[j]) + w1 * bf_hi(bq[j]) + w2 * bf_hi(cq[j]); r[j] = cvt_pk_bf16(lo, hi); }
        *(u32x4*)(ya + o) = r;
    }
}

__device__ __forceinline__ float ret_log2g(int h) { return __log2f(1.0f - fast_exp2(-5.0f - (float)h)); }

__device__ __forceinline__ void phase_kv(const Params& p, LAS unsigned char* lds, const int tid0) {
    const int tid = tid0, lane = tid & 63, w = tid >> 6, l15 = lane & 15, g4 = lane >> 4;
    LAS unsigned char* Ks = lds;
    LAS unsigned char* Vs = lds + 128 * 288;
    const bf16_t* rk = (const bf16_t*)(p.ws + WS_RK); const bf16_t* rv = (const bf16_t*)(p.ws + WS_RV);
    float* kv = (float*)(p.ws + WS_KV);
    for (int item = blockIdx.x; item < 1024; item += gridDim.x) {
        const int n = item & 63, bh = item >> 6, h = bh & 3, b = bh >> 2;
        const size_t tok0 = (size_t)b * SEQ + 128 * n;
        const float lg = ret_log2g(h);
#pragma unroll
        for (int it = 0; it < 4; ++it) { const int c = tid + 512 * it, j = c >> 4, ch = c & 15;
            const u32x4 q = *(const u32x4*)(rk + (tok0 + j) * RET_QK_W + h * 128 + ch * 8); const float z = fast_exp2((float)(127 - j) * lg);
            u32x4 o;
#pragma unroll
            for (int e = 0; e < 4; ++e) o[e] = cvt_pk_bf16(bf_lo(q[e]) * z, bf_hi(q[e]) * z);
            *(LAS u32x4*)(Ks + j * 288 + ch * 16) = o; }
#pragma unroll
        for (int it = 0; it < 8; ++it) { const int c = tid + 512 * it, j = c >> 5, ch = c & 31;
            *(LAS u32x4*)(Vs + j * 544 + ch * 16) = *(const u32x4*)(rv + (tok0 + j) * RET_V_W + h * 256 + ch * 8); }
        __syncthreads();
        f32x4 acc[2][8];
#pragma unroll
        for (int a = 0; a < 2; ++a)
#pragma unroll
            for (int d = 0; d < 8; ++d) acc[a][d] = (f32x4){0.f, 0.f, 0.f, 0.f};
#pragma unroll
        for (int kk = 0; kk < 4; ++kk) {
            const int rowb = 32 * kk + 4 * g4 + (l15 >> 2), colb = (4 * (l15 & 3)) * 2;
            bf16x8 af[2];
#pragma unroll
            for (int a = 0; a < 2; ++a) { const LAS unsigned char* vb = Vs + rowb * 544 + (2 * w + a) * 32 + colb; af[a] = cat8(lds_tr(vb), lds_tr(vb + 16 * 544)); }
#pragma unroll
            for (int d = 0; d < 8; ++d) { const LAS unsigned char* kb = Ks + rowb * 288 + d * 32 + colb; const bf16x8 bfr = cat8(lds_tr(kb), lds_tr(kb + 16 * 288));
#pragma unroll
                for (int a = 0; a < 2; ++a) acc[a][d] = __builtin_amdgcn_mfma_f32_16x16x32_bf16(af[a], bfr, acc[a][d], 0, 0, 0); }
        }
        float* dst = kv + (size_t)item * 32768;
#pragma unroll
        for (int a = 0; a < 2; ++a)
#pragma unroll
            for (int d = 0; d < 8; ++d)
#pragma unroll
                for (int rg = 0; rg < 4; ++rg) dst[(16 * (2 * w + a) + 4 * g4 + rg) * 128 + 16 * d + l15] = acc[a][d][rg];
        __syncthreads();
    }
}

__device__ __forceinline__ void phase_scan(const Params& p, const int tid0) {
    const float* __restrict__ kv = (const float*)(p.ws + WS_KV);
    bf16_t* __restrict__ rprev = (bf16_t*)((unsigned char*)p.out + DO_RPREV);
    for (int idx = blockIdx.x * 512 + tid0; idx < 16 * 8192; idx += gridDim.x * 512) {
        const int bh = idx >> 13, within = idx & 8191, h = bh & 3;
        const float gd = fast_exp2(128.0f * ret_log2g(h));
        f32x4 st = {0.f, 0.f, 0.f, 0.f};
        const size_t base = (size_t)bh * 64 * 32768 + (size_t)within * 4;
#pragma unroll 8
        for (int n = 0; n < 64; ++n) {
            u32x2 wv; wv.x = cvt_pk_bf16(st[0], st[1]); wv.y = cvt_pk_bf16(st[2], st[3]);
            *(u32x2*)(rprev + base + (size_t)n * 32768) = wv;
            const f32x4 k4 = *(const f32x4*)(kv + base + (size_t)n * 32768);
            st = st * gd + k4;
        }
    }
}

__device__ __forceinline__ void phase_ret(const Params& p, LAS unsigned char* lds, const int tid0) {
    const int tid = tid0, lane = tid & 63, w = __builtin_amdgcn_readfirstlane(tid >> 6), l15 = lane & 15, g4 = lane >> 4;
    LAS unsigned char* Ks = lds;
    LAS unsigned char* Vs = lds + 128 * 272;
    const bf16_t* rq = (const bf16_t*)(p.ws + WS_RQ); const bf16_t* rk = (const bf16_t*)(p.ws + WS_RK); const bf16_t* rv = (const bf16_t*)(p.ws + WS_RV); const bf16_t* srg = (const bf16_t*)(p.ws + WS_RG);
    const bf16_t* rprev = (const bf16_t*)((const unsigned char*)p.out + DO_RPREV);
    bf16_t* ro = (bf16_t*)(p.ws + WS_RO);
    for (int item = blockIdx.x; item < 1024; item += gridDim.x) {
        const int n = item & 63, bh = item >> 6, h = bh & 3, b = bh >> 2;
        const size_t tok0 = (size_t)b * SEQ + 128 * n;
        const float lg = ret_log2g(h);
#pragma unroll
        for (int it = 0; it < 4; ++it) { const int c = tid + 512 * it, j = c >> 4, ch = c & 15;
            *(LAS u32x4*)(Ks + j * 272 + ch * 16) = *(const u32x4*)(rk + (tok0 + j) * RET_QK_W + h * 128 + ch * 8); }
#pragma unroll
        for (int it = 0; it < 8; ++it) { const int c = tid + 512 * it, j = c >> 5, ch = c & 31;
            *(LAS u32x4*)(Vs + j * 544 + ch * 16) = *(const u32x4*)(rv + (tok0 + j) * RET_V_W + h * 256 + ch * 8); }
        const int i = 16 * w + l15; const size_t tq = tok0 + i;
        bf16x8 qf[4];
#pragma unroll
        for (int kk = 0; kk < 4; ++kk) qf[kk] = *(const bf16x8*)(rq + tq * RET_QK_W + h * 128 + 32 * kk + 8 * g4);
        __syncthreads();
        f32x4 acc[16];
#pragma unroll
        for (int et = 0; et < 16; ++et) acc[et] = (f32x4){0.f, 0.f, 0.f, 0.f};
        const bf16_t* rp = rprev + (size_t)item * 32768;
#pragma unroll
        for (int et = 0; et < 16; ++et)
#pragma unroll
            for (int kk = 0; kk < 4; ++kk) { const bf16x8 a = *(const bf16x8*)(rp + (16 * et + l15) * 128 + 32 * kk + 8 * g4); acc[et] = __builtin_amdgcn_mfma_f32_16x16x32_bf16(a, qf[kk], acc[et], 0, 0, 0); }
        const float xi = fast_exp2((float)(i + 1) * lg);
#pragma unroll
        for (int et = 0; et < 16; ++et) acc[et] = acc[et] * xi;
        bf16x8 pf[4];
#pragma unroll
        for (int s4 = 0; s4 < 4; ++s4) {
            u32x4 pw = {0u, 0u, 0u, 0u};
            if (2 * s4 <= w) {
                float pv[2][4];
#pragma unroll
                for (int u = 0; u < 2; ++u) { const int kt = 2 * s4 + u; f32x4 a4 = {0.f, 0.f, 0.f, 0.f};
#pragma unroll
                    for (int kk = 0; kk < 4; ++kk) { const bf16x8 kf = *(const LAS bf16x8*)(Ks + (16 * kt + l15) * 272 + (32 * kk + 8 * g4) * 2); a4 = __builtin_amdgcn_mfma_f32_16x16x32_bf16(kf, qf[kk], a4, 0, 0, 0); }
#pragma unroll
                    for (int rg = 0; rg < 4; ++rg) { const int j = 16 * kt + 4 * g4 + rg; pv[u][rg] = (j <= i) ? a4[rg] * fast_exp2((float)(i - j) * lg) : 0.f; } }
                pw.x = cvt_pk_bf16(pv[0][0], pv[0][1]); pw.y = cvt_pk_bf16(pv[0][2], pv[0][3]); pw.z = cvt_pk_bf16(pv[1][0], pv[1][1]); pw.w = cvt_pk_bf16(pv[1][2], pv[1][3]);
            }
            pf[s4] = __builtin_bit_cast(bf16x8, pw);
        }
#pragma unroll
        for (int s4 = 0; s4 < 4; ++s4) {
            if (2 * s4 <= w) {
                const LAS unsigned char* vb = Vs + (32 * s4 + 4 * g4 + (l15 >> 2)) * 544 + (4 * (l15 & 3)) * 2;
#pragma unroll
                for (int et = 0; et < 16; ++et) { const s16x4 lo = lds_tr(vb + et * 32), hi = lds_tr(vb + et * 32 + 16 * 544);
                    acc[et] = __builtin_amdgcn_mfma_f32_16x16x32_bf16(cat8(lo, hi), pf[s4], acc[et], 0, 0, 0); }
            }
        }
        float ss = 0.f;
#pragma unroll
        for (int et = 0; et < 16; ++et) ss += acc[et][0] * acc[et][0] + acc[et][1] * acc[et][1] + acc[et][2] * acc[et][2] + acc[et][3] * acc[et][3];
        ss += __shfl_xor(ss, 16); ss += __shfl_xor(ss, 32);
        const float rstd = rsqrtf(ss * (1.0f / 256.0f) + NORM_EPS);
#pragma unroll
        for (int et = 0; et < 16; ++et) { const size_t o = tq * RET_V_W + h * 256 + 16 * et + 4 * g4; const u32x2 gq = *(const u32x2*)(srg + o);
            u32x2 wv; wv.x = cvt_pk_bf16(acc[et][0] * rstd * bf_lo(gq.x), acc[et][1] * rstd * bf_hi(gq.x)); wv.y = cvt_pk_bf16(acc[et][2] * rstd * bf_lo(gq.y), acc[et][3] * rstd * bf_hi(gq.y));
            *(u32x2*)(ro + o) = wv; }
        __syncthreads();
    }
}

__device__ __forceinline__ void phase_rows(const Params& p, const int tid0) {
    const int lane = tid0 & 63, w = tid0 >> 6;
    const float* mod = (const float*)(p.ws + WS_MOD); const float* ym = (const float*)(p.ws + WS_YM);
    bf16_t* h2 = (bf16_t*)(p.ws + WS_H2);
    for (int row = blockIdx.x * 8 + w; row < T; row += gridDim.x * 8) {
        const int b = row / SEQ; const float* mb = mod + b * 6144;
        f32x4 v[4]; float ss = 0.f;
#pragma unroll
        for (int i = 0; i < 4; ++i) { v[i] = *(const f32x4*)(ym + (size_t)row * DM + i * 256 + lane * 4); ss += v[i][0] * v[i][0] + v[i][1] * v[i][1] + v[i][2] * v[i][2] + v[i][3] * v[i][3]; }
        ss = wave_sum(ss);
        const float rstd = rsqrtf(ss * (1.0f / DM) + NORM_EPS);
        float s1 = 0.f;
#pragma unroll
        for (int i = 0; i < 4; ++i) { const int c = i * 256 + lane * 4;
            const f32x4 xv = *(const f32x4*)(p.x + (size_t)row * DM + c), g = *(const f32x4*)(p.g_post_mix + c), gt = *(const f32x4*)(mb + 2048 + c);
#pragma unroll
            for (int j = 0; j < 4; ++j) { v[i][j] = xv[j] + gt[j] * (v[i][j] * rstd * g[j]); s1 += v[i][j] * v[i][j]; }
            *(f32x4*)(p.out + (size_t)row * DM + c) = v[i]; }
        s1 = wave_sum(s1);
        const float rstd1 = rsqrtf(s1 * (1.0f / DM) + NORM_EPS);
#pragma unroll
        for (int i = 0; i < 4; ++i) { const int c = i * 256 + lane * 4;
            const f32x4 g = *(const f32x4*)(p.g_pre_ffn + c), sh = *(const f32x4*)(mb + 3072 + c), sc = *(const f32x4*)(mb + 4096 + c);
            float o[4];
#pragma unroll
            for (int j = 0; j < 4; ++j) o[j] = v[i][j] * rstd1 * g[j] * (1.0f + sc[j]) + sh[j];
            u32x2 wv; wv.x = cvt_pk_bf16(o[0], o[1]); wv.y = cvt_pk_bf16(o[2], o[3]);
            *(u32x2*)(h2 + (size_t)row * DM + c) = wv; }
    }
    bf16_t* dn = (bf16_t*)(p.ws + WS_DN); bf16_t* up = (bf16_t*)(p.ws + WS_UP);
    for (size_t idx = (size_t)blockIdx.x * 512 + tid0; idx < (size_t)2 * 2097152; idx += (size_t)gridDim.x * 512) {
        const bool second = idx >= 2097152; const size_t e = (second ? idx - 2097152 : idx) * 8; const float* src = second ? p.up : p.down;
        const f32x4 a = *(const f32x4*)(src + e), b = *(const f32x4*)(src + e + 4);
        u32x4 wv; wv.x = cvt_pk_bf16(a[0], a[1]); wv.y = cvt_pk_bf16(a[2], a[3]); wv.z = cvt_pk_bf16(b[0], b[1]); wv.w = cvt_pk_bf16(b[2], b[3]);
        *(u32x4*)((second ? up : dn) + e) = wv;
    }
}

__device__ __forceinline__ unsigned f2key(float f) { const unsigned u = __float_as_uint(f); return u ^ ((unsigned)((int)u >> 31) | 0x80000000u); }
__device__ __forceinline__ float key2f(unsigned k) { return __uint_as_float((k & 0x80000000u) ? (k ^ 0x80000000u) : ~k); }
#define TOP_INSERT(top, xin) do { unsigned _x = (xin); _Pragma("unroll") for (int _j = 0; _j < 16; ++_j) { const unsigned _hi = top[_j] > _x ? top[_j] : _x; _x = top[_j] > _x ? _x : top[_j]; top[_j] = _hi; } } while (0)

__device__ __forceinline__ void phase_route(const Params& p, LAS unsigned char* lds, const int tid0) {
    const int tid = tid0, lane = tid & 63, w = tid >> 6, l15 = lane & 15, g4 = lane >> 4;
    const bf16_t* qp = (const bf16_t*)(p.ws + WS_QP); const bf16_t* keys = (const bf16_t*)(p.ws + WS_KEYS);
    int* ids = (int*)(p.ws + WS_IDS); float* gates = (float*)(p.ws + WS_GT);
    LAS unsigned* tab = (LAS unsigned*)lds + w * 512;
    for (int blk = blockIdx.x; blk < T / 128; blk += gridDim.x) {
        const int tok = blk * 128 + w * 16 + l15;
        for (int h = 0; h < 8; ++h) {
            unsigned vp[2][16];
#pragma unroll
            for (int half = 0; half < 2; ++half) {
                bf16x8 qf[4];
#pragma unroll
                for (int kk = 0; kk < 4; ++kk) qf[kk] = *(const bf16x8*)(qp + (size_t)tok * 2048 + h * 256 + half * 128 + 32 * kk + 8 * g4);
                const bf16_t* kb = keys + (size_t)half * 131072 + (size_t)h * 16384;
                unsigned top[16];
#pragma unroll
                for (int j = 0; j < 16; ++j) top[j] = 0u;
#pragma unroll
                for (int nt = 0; nt < 8; ++nt) { f32x4 a4 = {0.f, 0.f, 0.f, 0.f};
#pragma unroll
                    for (int kk = 0; kk < 4; ++kk) { const bf16x8 kf = *(const bf16x8*)(kb + (16 * nt + l15) * 128 + 32 * kk + 8 * g4); a4 = __builtin_amdgcn_mfma_f32_16x16x32_bf16(kf, qf[kk], a4, 0, 0, 0); }
#pragma unroll
                    for (int rg = 0; rg < 4; ++rg) { const unsigned k = (f2key(a4[rg]) & ~0x7Fu) | (unsigned)(16 * nt + 4 * g4 + rg); TOP_INSERT(top, k); } }
#pragma unroll
                for (int rnd = 16; rnd <= 32; rnd <<= 1) { unsigned oth[16];
#pragma unroll
                    for (int j = 0; j < 16; ++j) oth[j] = (unsigned)__shfl_xor((int)top[j], rnd);
#pragma unroll
                    for (int j = 0; j < 16; ++j) TOP_INSERT(top, oth[j]); }
#pragma unroll
                for (int j = 0; j < 16; ++j) vp[half][j] = top[j];
            }
            float f1[16], f2[16];
#pragma unroll
            for (int j = 0; j < 16; ++j) { f1[j] = key2f(vp[0][j] & ~0x7Fu); f2[j] = key2f(vp[1][j] & ~0x7Fu); }
            unsigned top[16];
#pragma unroll
            for (int j = 0; j < 16; ++j) top[j] = 0u;
#pragma unroll
            for (int a = 0; a < 16; ++a)
#pragma unroll
                for (int b = 0; b < 16; ++b) if ((a + 1) * (b + 1) <= 16) { const unsigned k = (f2key(f1[a] + f2[b]) & ~0xFFu) | (unsigned)(a * 16 + b); TOP_INSERT(top, k); }
            const float m = key2f(top[0]); float e[16], se = 0.f;
#pragma unroll
            for (int j = 0; j < 16; ++j) { e[j] = __expf(key2f(top[j]) - m); se += e[j]; }
            const float ise = 1.0f / se;
            __syncthreads();
            if (g4 == 0) {
#pragma unroll
                for (int j = 0; j < 16; ++j) { tab[l15 * 32 + j] = vp[0][j]; tab[l15 * 32 + 16 + j] = vp[1][j]; } }
            __syncthreads();
#pragma unroll
            for (int jj = 0; jj < 4; ++jj) {
                const unsigned k = g4 == 0 ? top[jj] : g4 == 1 ? top[4 + jj] : g4 == 2 ? top[8 + jj] : top[12 + jj];
                const float gt = (g4 == 0 ? e[jj] : g4 == 1 ? e[4 + jj] : g4 == 2 ? e[8 + jj] : e[12 + jj]) * ise;
                const int a = (k >> 4) & 15, b = k & 15;
                const int i1 = tab[l15 * 32 + a] & 0x7F, i2 = tab[l15 * 32 + 16 + b] & 0x7F;
                ids[(size_t)tok * 128 + h * 16 + 4 * g4 + jj] = i1 * 128 + i2;
                gates[(size_t)tok * 128 + h * 16 + 4 * g4 + jj] = gt;
            }
        }
    }
}

__device__ __forceinline__ void phase_experts(const Params& p, const int tid0) {
    const int lane = tid0 & 63, w = tid0 >> 6;
    const bf16_t* h2 = (const bf16_t*)(p.ws + WS_H2); const bf16_t* dn = (const bf16_t*)(p.ws + WS_DN); const bf16_t* up = (const bf16_t*)(p.ws + WS_UP);
    const int* ids = (const int*)(p.ws + WS_IDS); const float* gates = (const float*)(p.ws + WS_GT);
    const float* mod = (const float*)(p.ws + WS_MOD);
    for (int tok = blockIdx.x * 8 + w; tok < T; tok += gridDim.x * 8) {
        const int b = tok / SEQ;
        float xv[16];
        { const u32x4 a = *(const u32x4*)(h2 + (size_t)tok * DM + lane * 16), c = *(const u32x4*)(h2 + (size_t)tok * DM + lane * 16 + 8);
#pragma unroll
          for (int j = 0; j < 4; ++j) { xv[2 * j] = bf_lo(a[j]); xv[2 * j + 1] = bf_hi(a[j]); xv[8 + 2 * j] = bf_lo(c[j]); xv[9 + 2 * j] = bf_hi(c[j]); } }
        const int idA = ids[(size_t)tok * 128 + lane], idB = ids[(size_t)tok * 128 + 64 + lane];
        const float gA = gates[(size_t)tok * 128 + lane], gB = gates[(size_t)tok * 128 + 64 + lane];
        float f[16];
#pragma unroll
        for (int j = 0; j < 16; ++j) f[j] = 0.f;
        for (int e0 = 0; e0 < 128; e0 += 4) {
            int id[4]; float gt[4], dot[4];
#pragma unroll
            for (int u = 0; u < 4; ++u) { const int e = e0 + u; id[u] = __shfl(e < 64 ? idA : idB, e & 63); gt[u] = __shfl(e < 64 ? gA : gB, e & 63); }
            u32x4 da[4], db[4];
#pragma unroll
            for (int u = 0; u < 4; ++u) { const bf16_t* r = dn + (size_t)id[u] * DM + lane * 16; da[u] = *(const u32x4*)r; db[u] = *(const u32x4*)(r + 8); }
            u32x4 ua[4], ub[4];
#pragma unroll
            for (int u = 0; u < 4; ++u) { const bf16_t* r = up + (size_t)id[u] * DM + lane * 16; ua[u] = *(const u32x4*)r; ub[u] = *(const u32x4*)(r + 8); }
#pragma unroll
            for (int u = 0; u < 4; ++u) { float s = 0.f;
#pragma unroll
                for (int j = 0; j < 4; ++j) { s += bf_lo(da[u][j]) * xv[2 * j] + bf_hi(da[u][j]) * xv[2 * j + 1]; s += bf_lo(db[u][j]) * xv[8 + 2 * j] + bf_hi(db[u][j]) * xv[9 + 2 * j]; }
                dot[u] = wave_sum(s); }
#pragma unroll
            for (int u = 0; u < 4; ++u) { const float a = dot[u]; const float wgt = gt[u] * 0.5f * a * (1.0f + erff(a * 0.7071067811865476f));
#pragma unroll
                for (int j = 0; j < 4; ++j) { f[2 * j] += wgt * bf_lo(ua[u][j]); f[2 * j + 1] += wgt * bf_hi(ua[u][j]); f[8 + 2 * j] += wgt * bf_lo(ub[u][j]); f[9 + 2 * j] += wgt * bf_hi(ub[u][j]); } }
        }
        float ss = 0.f;
#pragma unroll
        for (int j = 0; j < 16; ++j) ss += f[j] * f[j];
        ss = wave_sum(ss);
        const float rstd = rsqrtf(ss * (1.0f / DM) + NORM_EPS);
        float* op = p.out + (size_t)tok * DM + lane * 16;
#pragma unroll
        for (int q = 0; q < 4; ++q) { const int c = lane * 16 + q * 4;
            const f32x4 x1 = *(const f32x4*)(op + q * 4), g = *(const f32x4*)(p.g_post_ffn + c), gt2 = *(const f32x4*)(mod + b * 6144 + 5120 + c);
            f32x4 o;
#pragma unroll
            for (int j = 0; j < 4; ++j) o[j] = x1[j] + gt2[j] * (f[q * 4 + j] * rstd * g[j]);
            *(f32x4*)(op + q * 4) = o; }
    }
}

constexpr int NPH = 15;
__device__ __forceinline__ void run_gemm(LAS unsigned char* lds, const bf16_t* A, const bf16_t* Bt, int N, int K, int kind, unsigned char* ws, unsigned char* dout) {
    pg8::Gemm g{A, Bt, T, N, K}; EpiGen E{kind, ws, dout}; pg8::StaticOrder S; S.init(g.M, g.N, (int)gridDim.x, (int)blockIdx.x); pg8::gemm_phase<EpiGen, pg8::StaticOrder>(lds, g, S, E);
}
__global__ void __launch_bounds__(512, 2) fwd_kernel(Params p) {
    extern __shared__ __attribute__((aligned(16))) unsigned char shm[];
    LAS unsigned char* lds = (LAS unsigned char*)shm;
    cg::grid_group grid = cg::this_grid();
    const int lo = (int)p.ph_lo, hi = (int)p.ph_hi;
    unsigned char* const dout = (unsigned char*)p.out;
#define PHASE(k, body) if (lo <= (k) && (k) < hi) { const int tid0 = threadIdx.x; body; if ((k) + 1 < hi) grid.sync(); }
    PHASE(0, phase_prep(p, lds, tid0))
    PHASE(1, phase_h(p, tid0))
    PHASE(2, run_gemm(lds, (const bf16_t*)(dout + DO_H), (const bf16_t*)(p.ws + WS_WIN_T), NA, 1024, EK_A, p.ws, dout))
    PHASE(3, phase_attn(p, lds, tid0))
    PHASE(4, phase_combine(p, tid0); __syncthreads(); run_gemm(lds, (const bf16_t*)(dout + DO_H), (const bf16_t*)(p.ws + WS_WIN_T) + (size_t)NA * 1024, NBC, 1024, EK_B, p.ws, dout))
    PHASE(5, phase_kv(p, lds, tid0))
    PHASE(6, phase_scan(p, tid0))
    PHASE(7, phase_ret(p, lds, tid0))
    PHASE(8, run_gemm(lds, (const bf16_t*)(dout + DO_YATT), (const bf16_t*)(p.ws + WS_WA_T), 1024, 512, EK_C, p.ws, dout))
    PHASE(9, run_gemm(lds, (const bf16_t*)(p.ws + WS_RO), (const bf16_t*)(p.ws + WS_WR_T), 1024, 1024, EK_D, p.ws, dout))
    PHASE(10, run_gemm(lds, (const bf16_t*)(p.ws + WS_Y), (const bf16_t*)(p.ws + WS_WMX_T), 1024, 1024, EK_E, p.ws, dout))
    PHASE(11, phase_rows(p, tid0))
    PHASE(12, run_gemm(lds, (const bf16_t*)(p.ws + WS_H2), (const bf16_t*)(p.ws + WS_WPQ_T), 2048, 1024, EK_F, p.ws, dout))
    PHASE(13, phase_route(p, lds, tid0))
    PHASE(14, phase_experts(p, tid0))
#undef PHASE
}

extern "C" void kernel_launch(void* const* d_in, const int* in_sizes, int n_in, void* d_out, int out_size, void* d_ws, size_t ws_size, hipStream_t stream) {
    static int grid_blocks = 0;
    if (grid_blocks == 0) {
        if (n_in != 18 || ws_size < WS_END) { fprintf(stderr, "kernel_launch: unexpected n_in %d / ws_size %zu\n", n_in, ws_size); grid_blocks = -1; return; }
        int dev = 0, cus = 0, per_cu = 0;
        hipGetDevice(&dev); hipDeviceGetAttribute(&cus, hipDeviceAttributeMultiprocessorCount, dev);
        if (hipFuncSetAttribute((const void*)fwd_kernel, hipFuncAttributeMaxDynamicSharedMemorySize, LDS_BYTES) != hipSuccess) { fprintf(stderr, "kernel_launch: hipFuncSetAttribute failed\n"); grid_blocks = -1; return; }
        hipOccupancyMaxActiveBlocksPerMultiprocessor(&per_cu, (const void*)fwd_kernel, 512, LDS_BYTES);
        if (per_cu < 1) { fprintf(stderr, "kernel_launch: occupancy query says %d blocks per CU\n", per_cu); per_cu = 1; }
        grid_blocks = cus;
        (void)hipGetLastError();
    }
    if (grid_blocks < 0) return;
    Params p{};
    p.x = (const float*)d_in[0]; p.c = (const float*)d_in[1]; p.pos = (const int*)d_in[2]; p.w_ada = (const float*)d_in[3]; p.b_ada = (const float*)d_in[4];
    p.g_pre_mix = (const float*)d_in[5]; p.g_post_mix = (const float*)d_in[6]; p.w_in = (const float*)d_in[7]; p.w_att = (const float*)d_in[8]; p.w_ret = (const float*)d_in[9];
    p.w_mix = (const float*)d_in[10]; p.g_pre_ffn = (const float*)d_in[11]; p.g_post_ffn = (const float*)d_in[12]; p.w_pq = (const float*)d_in[13]; p.keys1 = (const float*)d_in[14];
    p.keys2 = (const float*)d_in[15]; p.down = (const float*)d_in[16]; p.up = (const float*)d_in[17]; p.out = (float*)d_out; p.ws = (unsigned char*)d_ws;
#if defined(MULTI_LAUNCH)
    for (int ph = 0; ph < NPH; ++ph) { p.ph_lo = ph; p.ph_hi = ph + 1; hipLaunchKernelGGL(fwd_kernel, dim3(grid_blocks), dim3(512), LDS_BYTES, stream, p); }
#else
    p.ph_lo = 0; p.ph_hi = NPH;
    void* args[] = {&p};
    hipError_t e = hipLaunchCooperativeKernel((const void*)fwd_kernel, dim3(grid_blocks), dim3(512), args, LDS_BYTES, stream);
    if (e != hipSuccess) fprintf(stderr, "cooperative launch failed: %s (grid %d)\n", hipGetErrorString(e), grid_blocks);
#endif
}
```

```cpp
#include <hip/hip_runtime.h>
#include <hip/hip_cooperative_groups.h>
#include <cstdio>
namespace cg = cooperative_groups;

#define LAS __attribute__((address_space(3)))
typedef unsigned short bf16_t;
typedef short bf16x8 __attribute__((ext_vector_type(8)));
typedef short s16x4 __attribute__((ext_vector_type(4)));
typedef float f32x4 __attribute__((ext_vector_type(4)));
typedef float f32x2 __attribute__((ext_vector_type(2)));
typedef unsigned u32x4 __attribute__((ext_vector_type(4)));
typedef unsigned u32x2 __attribute__((ext_vector_type(2)));

constexpr int NB = 4, SEQ = 8192, T = NB * SEQ, DM = 1024;
constexpr int ATT_W = 1536, RET_QK_W = 512, RET_V_W = 1024, IN_W = 9728;
constexpr int NA = 4608;
constexpr int NBC = 5120;
constexpr float NORM_EPS = 1e-6f;
constexpr size_t MiB = 1ull << 20;

constexpr size_t WS_CTL   = 0;
constexpr size_t WS_MOD   = 65536;
constexpr size_t WS_WIN_T = 1 * MiB;
constexpr size_t WS_WA_T  = 20 * MiB;
constexpr size_t WS_WR_T  = 21 * MiB;
constexpr size_t WS_WMX_T = 23 * MiB;
constexpr size_t WS_WPQ_T = 25 * MiB;
constexpr size_t WS_KEYS  = 29 * MiB;
constexpr size_t WS_ROPE  = 30 * MiB;
constexpr size_t WS_R1    = 48 * MiB;
constexpr size_t WS_AQ = WS_R1, WS_AK = WS_R1 + 96 * MiB, WS_AV = WS_R1 + 192 * MiB;
constexpr size_t WS_RQ = WS_R1, WS_RK = WS_R1 + 32 * MiB, WS_RV = WS_R1 + 64 * MiB, WS_RG = WS_R1 + 128 * MiB, WS_GA = WS_R1 + 192 * MiB;
constexpr size_t WS_KV = 304 * MiB;
constexpr size_t WS_RO = 304 * MiB;
constexpr size_t WS_OG = 336 * MiB;
constexpr size_t WS_LSE = 432 * MiB;
constexpr size_t WS_GR = 434 * MiB;
constexpr size_t WS_Y1 = WS_R1;
constexpr size_t WS_Y  = WS_R1 + 64 * MiB;
constexpr size_t WS_YM = WS_R1 + 128 * MiB;
constexpr size_t WS_H2 = WS_R1;
constexpr size_t WS_DN = 304 * MiB;
constexpr size_t WS_UP = 368 * MiB;
constexpr size_t WS_QP = WS_R1 + 64 * MiB;
constexpr size_t WS_X1B = 240 * MiB;
constexpr size_t WS_IDS = 320 * MiB;
constexpr size_t WS_GT  = 336 * MiB;
constexpr size_t WS_F   = WS_R1 + 64 * MiB;
constexpr size_t WS_SSQ = 466 * MiB;
constexpr size_t WS_WB  = 352 * MiB;
constexpr size_t WS_H2Q = 434 * MiB;
constexpr size_t WS_SX  = 498 * MiB;
constexpr size_t WS_SDN = 499 * MiB;
constexpr size_t WS_SUP = 499 * MiB + 65536;
constexpr size_t WS_END = 500 * MiB;
constexpr size_t DO_H = 0, DO_YATT = 64 * MiB, DO_RPREV = 0;

constexpr int LDS_MAIN = 143360, LDS_BYTES = LDS_MAIN + 16;

struct Params {
    const float* x; const float* c; const int* pos; const float* w_ada; const float* b_ada; const float* g_pre_mix; const float* g_post_mix; const float* w_in;
    const float* w_att; const float* w_ret; const float* w_mix; const float* g_pre_ffn; const float* g_post_ffn; const float* w_pq; const float* keys1; const float* keys2;
    const float* down; const float* up; float* out; unsigned char* ws; long long ph_lo, ph_hi, rep_mask;
};

__device__ __forceinline__ unsigned cvt_pk_bf16(float lo, float hi) { unsigned r; asm("v_cvt_pk_bf16_f32 %0, %1, %2" : "=v"(r) : "v"(lo), "v"(hi)); return r; }
__device__ __forceinline__ float bf_lo(unsigned u) { return __uint_as_float(u << 16); }
__device__ __forceinline__ float bf_hi(unsigned u) { return __uint_as_float(u & 0xffff0000u); }
__device__ __forceinline__ int dpp_i(int v, const int ctrl) { return ctrl == 0xB1 ? __builtin_amdgcn_update_dpp(0, v, 0xB1, 0xF, 0xF, false) : ctrl == 0x4E ? __builtin_amdgcn_update_dpp(0, v, 0x4E, 0xF, 0xF, false) : ctrl == 0x141 ? __builtin_amdgcn_update_dpp(0, v, 0x141, 0xF, 0xF, false) : __builtin_amdgcn_update_dpp(0, v, 0x140, 0xF, 0xF, false); }
__device__ __forceinline__ float dpp_f(float v, const int ctrl) { return __uint_as_float((unsigned)dpp_i((int)__float_as_uint(v), ctrl)); }
__device__ __forceinline__ int row16_sum_i(int d) { d += dpp_i(d, 0xB1); d += dpp_i(d, 0x4E); d += dpp_i(d, 0x141); d += dpp_i(d, 0x140); return d; }
__device__ __forceinline__ float row16_sum_f(float d) { d += dpp_f(d, 0xB1); d += dpp_f(d, 0x4E); d += dpp_f(d, 0x141); d += dpp_f(d, 0x140); return d; }
__device__ __forceinline__ float row16_max_f(float d) { d = fmaxf(d, dpp_f(d, 0xB1)); d = fmaxf(d, dpp_f(d, 0x4E)); d = fmaxf(d, dpp_f(d, 0x141)); d = fmaxf(d, dpp_f(d, 0x140)); return d; }
__device__ __forceinline__ float wave_sum(float v) { v = row16_sum_f(v); v += __shfl_xor(v, 16); v += __shfl_xor(v, 32); return v; }
__device__ __forceinline__ float fast_exp2(float x) { return __builtin_amdgcn_exp2f(x); }
__device__ __forceinline__ float sigmoidf_(float x) { return 1.0f / (1.0f + __expf(-x)); }
__device__ __forceinline__ int perm_logical(int nphys, bool rope) {
    const int p = nphys & 255, base = nphys & ~255, lo = 8 * ((p >> 2) & 3) + 4 * ((p >> 4) & 1) + (p & 3);
    return rope ? base + 128 * ((p >> 6) & 1) + 64 * (p >> 7) + 32 * ((p >> 5) & 1) + lo : base + (p & ~31) + lo;
}
__device__ __forceinline__ s16x4 lds_tr(const LAS unsigned char* a) { return __builtin_amdgcn_ds_read_tr16_b64_v4i16((LAS s16x4*)a); }
__device__ __forceinline__ bf16x8 cat8(s16x4 lo, s16x4 hi) { return (bf16x8){lo[0], lo[1], lo[2], lo[3], hi[0], hi[1], hi[2], hi[3]}; }
namespace pg8 {
constexpr int BM = 256, BK = 64, HALF = 128, HTB = HALF * BK * 2  , STAGE_BYTES = 8 * HTB, NXCD = 8, WGM = 8;

__host__ __device__ __forceinline__ int lds_byte(int r, int c) { const int st = (r >> 4) * 2 + (c >> 5), rr = r & 15, cc = c & 31, ob = rr * 64 + cc * 2; return st * 1024 + (ob ^ (((ob >> 9) & 1) << 5)); }
__host__ __device__ __forceinline__ void stage_rc(int b, int& R, int& C) { const int st = b / 1024, sb = b % 1024, swz = sb ^ (((sb >> 9) & 1) << 5); R = (st >> 1) * 16 + swz / 64; C = (st & 1) * 32 + (swz % 64) / 2; }
__host__ __device__ __forceinline__ int perm32(int rho) { const int n = rho >> 4, i = rho & 15; return 8 * (i >> 2) + 4 * n + (i & 3); }

struct Unit { int pm, pn; };
struct Gemm { const bf16_t* A; const bf16_t* Bt; int M, N, K; };

struct StaticOrder {
    int nM, nN, nwg, G, c;
    __host__ __device__ void init(int M, int N, int G_, int c_) { nM = M / BM; nN = N / BM; nwg = nM * nN; G = G_; c = c_; }
    __host__ __device__ bool next(int i, Unit& u) const {
        const long L = (long)i * G + c; if (L >= nwg) return false;
        int wgid = (int)L; { const int q = nwg / NXCD, r = nwg % NXCD, xcd = wgid % NXCD, off = wgid / NXCD; wgid = (xcd < r ? xcd * (q + 1) : r * (q + 1) + (xcd - r) * q) + off; }
        const int nig = WGM * nN, gid = wgid / nig, fm = gid * WGM, gsz = (nM - fm) < WGM ? (nM - fm) : WGM;
        u.pm = fm + ((wgid % nig) % gsz); u.pn = (wgid % nig) / gsz; return true;
    }
    __device__ __forceinline__ void a_ready(const Unit&) const {}
    __device__ __forceinline__ void done(const Unit&) const {}
};

template <class Epi, class Sched>
__device__ __forceinline__ void gemm_phase(LAS unsigned char* lds, const Gemm g, const Sched& S, const Epi& E) {
    const int tid = threadIdx.x, wid = __builtin_amdgcn_readfirstlane(tid >> 6), lane = tid & 63, wr = wid >> 2, wc = wid & 3, fr = lane & 15, fq = lane >> 4;
    const int K = g.K, nt = K / BK;
    unsigned voffA[2], voffB[2];
#pragma unroll
    for (int i = 0; i < 2; ++i) { int R, C; stage_rc(tid * 16 + i * 8192, R, C); const int Rb = Epi::PERM ? ((R & ~31) + perm32(R & 31)) : R;
        voffA[i] = (unsigned)(R * K + C) * 2u; voffB[i] = (unsigned)(Rb * K + C) * 2u; }
    const size_t kstep = (size_t)(BK * 2);
    const size_t hstep = (size_t)HALF * K * 2;
    const size_t tstep = 2 * hstep;
    const unsigned ldsw = (unsigned)wid * 1024u;
    const int aoff = lds_byte(wr * 64 + fr, fq * 8), boff = lds_byte(wc * 32 + fr, fq * 8);
#define PG8_SA(b, h) (((b) * 2 + (h)) * HTB)
#define PG8_SB(b, h) ((4 + (b) * 2 + (h)) * HTB)
#define PG8_STAGE(bufoff, gbase, voff) do { _Pragma("unroll") for (int _i = 0; _i < 2; ++_i) \
        __builtin_amdgcn_global_load_lds((const unsigned*)((const char*)(gbase) + (voff)[_i]), (LAS unsigned*)(lds + (bufoff) + ldsw + _i * 8192), 16, 0, 0); } while (0)
#define PG8_LDA(dst, b, h) do { _Pragma("unroll") for (int m = 0; m < 4; ++m) _Pragma("unroll") for (int k = 0; k < 2; ++k) dst[m][k] = *(const LAS bf16x8*)(lds + PG8_SA(b, h) + aoff + m * 2048 + k * 1024); } while (0)
#define PG8_LDB(dst, b, h) do { _Pragma("unroll") for (int n = 0; n < 2; ++n) _Pragma("unroll") for (int k = 0; k < 2; ++k) dst[n][k] = *(const LAS bf16x8*)(lds + PG8_SB(b, h) + boff + n * 2048 + k * 1024); } while (0)
#define PG8_MMA(ai, bj, At, Bt) do { __builtin_amdgcn_s_setprio(1); _Pragma("unroll") for (int m = 0; m < 4; ++m) _Pragma("unroll") for (int n = 0; n < 2; ++n) _Pragma("unroll") for (int k = 0; k < 2; ++k) \
        acc[ai][bj][m][n] = __builtin_amdgcn_mfma_f32_16x16x32_bf16(Bt[n][k], At[m][k], acc[ai][bj][m][n], 0, 0, 0); __builtin_amdgcn_s_setprio(0); } while (0)
#define PG8_WAIT_V(n) asm volatile("s_waitcnt vmcnt(" #n ")" ::: "memory")
#define PG8_WAIT_L(n) asm volatile("s_waitcnt lgkmcnt(" #n ")" ::: "memory")
#define PG8_BAR __builtin_amdgcn_s_barrier()
#define PG8_SCHED __builtin_amdgcn_sched_barrier(0)
    Unit cur, nxt; int ui = 0;
    if (!S.next(0, cur)) return;
    f32x4 acc[2][2][4][2];
#pragma unroll
    for (int a = 0; a < 2; ++a)
#pragma unroll
        for (int b = 0; b < 2; ++b)
#pragma unroll
            for (int m = 0; m < 4; ++m)
#pragma unroll
                for (int n = 0; n < 2; ++n) acc[a][b][m][n] = (f32x4){0.f, 0.f, 0.f, 0.f};
    bf16x8 At[4][2], B0[2][2], B1[2][2];
    const char* cA = (const char*)g.A + (size_t)cur.pm * tstep; const char* cB = (const char*)g.Bt + (size_t)cur.pn * tstep;
    S.a_ready(cur);
    PG8_STAGE(PG8_SB(0, 0), cB, voffB); PG8_STAGE(PG8_SA(0, 0), cA, voffA); PG8_STAGE(PG8_SB(0, 1), cB + hstep, voffB); PG8_STAGE(PG8_SA(0, 1), cA + hstep, voffA);
    if (wr == 1) PG8_BAR;
    PG8_WAIT_V(4); PG8_BAR;
    PG8_STAGE(PG8_SB(1, 0), cB + kstep, voffB); PG8_STAGE(PG8_SA(1, 0), cA + kstep, voffA); PG8_STAGE(PG8_SB(1, 1), cB + hstep + kstep, voffB);
    PG8_WAIT_V(6); PG8_BAR;
    for (;;) {
        const bool has_next = S.next(ui + 1, nxt);
        const char* nA = has_next ? (const char*)g.A + (size_t)nxt.pm * tstep : cA; const char* nB = has_next ? (const char*)g.Bt + (size_t)nxt.pn * tstep : cB;
        for (int t = 0; t < nt; t += 2) {
            const bool last = (t == nt - 2);
            const char* a1 = cA + (size_t)(t + 1) * kstep;
            const char* a2 = last ? nA : cA + (size_t)(t + 2) * kstep; const char* b2 = last ? nB : cB + (size_t)(t + 2) * kstep;
            const char* a3 = a2 + kstep; const char* b3 = b2 + kstep;
            if (last && has_next) S.a_ready(nxt);
            PG8_LDB(B0, 0, 0); PG8_SCHED; PG8_LDA(At, 0, 0); PG8_STAGE(PG8_SA(1, 1), a1 + hstep, voffA);
            PG8_WAIT_L(8); PG8_BAR; PG8_WAIT_L(0); PG8_MMA(0, 0, At, B0); PG8_BAR; PG8_SCHED;
            PG8_LDB(B1, 0, 1); PG8_STAGE(PG8_SB(0, 0), b2, voffB);
            PG8_BAR; PG8_WAIT_L(0); PG8_MMA(0, 1, At, B1); PG8_BAR;
            PG8_LDA(At, 0, 1); PG8_STAGE(PG8_SA(0, 0), a2, voffA);
            PG8_BAR; PG8_WAIT_L(0); PG8_MMA(1, 0, At, B0); PG8_BAR; PG8_SCHED;
            PG8_STAGE(PG8_SB(0, 1), b2 + hstep, voffB);
            PG8_WAIT_V(6); PG8_BAR; PG8_MMA(1, 1, At, B1); PG8_BAR;
            PG8_LDB(B0, 1, 0); PG8_SCHED; PG8_LDA(At, 1, 0); PG8_STAGE(PG8_SA(0, 1), a2 + hstep, voffA);
            PG8_WAIT_L(8); PG8_BAR; PG8_WAIT_L(0); PG8_MMA(0, 0, At, B0); PG8_BAR; PG8_SCHED;
            PG8_LDB(B1, 1, 1); PG8_STAGE(PG8_SB(1, 0), b3, voffB);
            PG8_BAR; PG8_WAIT_L(0); PG8_MMA(0, 1, At, B1); PG8_BAR;
            PG8_LDA(At, 1, 1); PG8_STAGE(PG8_SA(1, 0), a3, voffA);
            PG8_BAR; PG8_WAIT_L(0); PG8_MMA(1, 0, At, B0); PG8_BAR; PG8_SCHED;
            PG8_STAGE(PG8_SB(1, 1), b3 + hstep, voffB);
            PG8_WAIT_V(6); PG8_BAR; PG8_MMA(1, 1, At, B1); PG8_BAR;
        }
        if constexpr (!Epi::AFTER_DRAIN) { E(acc, cur, wr, wc, fr, fq); S.done(cur); }
        if (!has_next) break;
#pragma unroll
        for (int a = 0; a < 2; ++a)
#pragma unroll
            for (int b = 0; b < 2; ++b)
#pragma unroll
                for (int m = 0; m < 4; ++m)
#pragma unroll
                    for (int n = 0; n < 2; ++n) acc[a][b][m][n] = (f32x4){0.f, 0.f, 0.f, 0.f};
        cur = nxt; cA = nA; cB = nB; ++ui;
    }
    PG8_WAIT_V(0);
    if (wr == 0) PG8_BAR;
    PG8_BAR;
    if constexpr (Epi::AFTER_DRAIN) { E.fused(acc, cur, wr, wc, fr, fq, lds, wid, lane); S.done(cur); }
#undef PG8_SA
#undef PG8_SB
#undef PG8_STAGE
#undef PG8_LDA
#undef PG8_LDB
#undef PG8_MMA
#undef PG8_WAIT_V
#undef PG8_WAIT_L
#undef PG8_BAR
#undef PG8_SCHED
}
}


__device__ __forceinline__ size_t att_row_off(int tok, int h12) { const int b = tok >> 13, s = tok & (SEQ - 1), dsh = (h12 >> 2) * 2; const int ps = ((s & ((1 << dsh) - 1)) << (13 - dsh)) + (s >> dsh); return ((size_t)(b * 12 + h12) * SEQ + ps) * 128; }
enum { EK_A = 0, EK_B = 1, EK_C = 2, EK_D = 3, EK_E = 4, EK_F = 5 };
struct EpiGen {
    static constexpr bool PERM = false, AFTER_DRAIN = false;
    int kind; unsigned char* ws; unsigned char* dout;
    __device__ __forceinline__ void operator()(const f32x4 (&acc)[2][2][4][2], const pg8::Unit& u, int wr, int wc, int fr, int fq) const {
        int mode = 0, ld = 1024, colbase = 0; size_t dsto = 0; float sc = 1.0f;
        const int pn = u.pn;
        bool attl = false;
        if (kind == EK_A) { const int tq = pn / 6; colbase = (pn - tq * 6) * 256; ld = ATT_W; dsto = WS_AQ + (size_t)tq * 96 * MiB; mode = tq < 2 ? 1 : 0; sc = tq == 0 ? 0.08838834764831845f * 1.4426950408889634f : 1.0f; attl = true; }
        else if (kind == EK_B) {
            if (pn < 2)       { mode = 1; ld = RET_QK_W; colbase = pn * 256; dsto = WS_RQ; }
            else if (pn < 4)  { mode = 1; ld = RET_QK_W; colbase = (pn - 2) * 256; dsto = WS_RK; sc = 0.08838834764831845f; }
            else if (pn < 8)  { mode = 0; colbase = (pn - 4) * 256; dsto = WS_RV; }
            else if (pn < 12) { mode = 2; colbase = (pn - 8) * 256; dsto = WS_RG; }
            else if (pn < 16) { mode = 3; colbase = (pn - 12) * 256; dsto = WS_GA; }
            else              { mode = 3; colbase = (pn - 16) * 256; dsto = WS_GR; }
        }
        else if (kind == EK_C) { mode = 4; colbase = pn * 256; dsto = WS_Y1; }
        else if (kind == EK_D) { mode = 5; colbase = pn * 256; dsto = WS_Y; }
        else if (kind == EK_E) { mode = 0; colbase = pn * 256; dsto = WS_YM; }
        else                   { mode = 0; ld = 2048; colbase = pn * 256; dsto = WS_QP; }
        const int row0 = u.pm * 256 + wr * 64 + fr;
        if (mode == 1) {
            bf16_t* dst = (bf16_t*)(ws + dsto);
            const float* rope = (const float*)(ws + WS_ROPE);
            const int d0 = 32 * (wc & 1) + 8 * fq, cb = colbase + 128 * (wc >> 1) + d0;
#pragma unroll
            for (int ai = 0; ai < 2; ++ai) {
                f32x4 cs[4][4];
#pragma unroll
                for (int m = 0; m < 4; ++m) { const float* rp = rope + ((size_t)(row0 + ai * 128 + m * 16) * 64 + d0) * 2;
#pragma unroll
                    for (int q = 0; q < 4; ++q) cs[m][q] = *(const f32x4*)(rp + 4 * q); }
#pragma unroll
                for (int m = 0; m < 4; ++m) {
                    const int row = row0 + ai * 128 + m * 16;
                    u32x4 w1, w2;
#pragma unroll
                    for (int n = 0; n < 2; ++n) {
                        const f32x4 cs0 = cs[m][2 * n], cs1 = cs[m][2 * n + 1];
                        const f32x4 x1 = acc[ai][0][m][n], x2 = acc[ai][1][m][n];
                        const float cc[4] = {cs0[0], cs0[2], cs1[0], cs1[2]}, ss[4] = {cs0[1], cs0[3], cs1[1], cs1[3]};
                        float o1[4], o2[4];
#pragma unroll
                        for (int i = 0; i < 4; ++i) { o1[i] = (x1[i] * cc[i] - x2[i] * ss[i]) * sc; o2[i] = (x1[i] * ss[i] + x2[i] * cc[i]) * sc; }
                        w1[2 * n] = cvt_pk_bf16(o1[0], o1[1]); w1[2 * n + 1] = cvt_pk_bf16(o1[2], o1[3]); w2[2 * n] = cvt_pk_bf16(o2[0], o2[1]); w2[2 * n + 1] = cvt_pk_bf16(o2[2], o2[3]);
                    }
                    bf16_t* op = attl ? dst + att_row_off(row, (colbase >> 7) + (wc >> 1)) + d0 : dst + (size_t)row * ld + cb;
                    *(u32x4*)op = w1; *(u32x4*)(op + 64) = w2;
                }
            }
        } else {
            bf16_t* dst = (bf16_t*)(ws + dsto);
            const bf16_t* gate = (const bf16_t*)(ws + (mode == 4 ? WS_GA : WS_GR));
            const bf16_t* y1 = (const bf16_t*)(ws + WS_Y1);
#pragma unroll
            for (int ai = 0; ai < 2; ++ai) {
                u32x4 gq[4][2], yq[4][2];
                if (mode >= 4) {
#pragma unroll
                    for (int m = 0; m < 4; ++m)
#pragma unroll
                        for (int bj = 0; bj < 2; ++bj) { const size_t o = (size_t)(row0 + ai * 128 + m * 16) * ld + colbase + wc * 32 + 8 * fq + bj * 128; gq[m][bj] = *(const u32x4*)(gate + o); if (mode == 5) yq[m][bj] = *(const u32x4*)(y1 + o); }
                }
#pragma unroll
                for (int m = 0; m < 4; ++m) {
                    const size_t ro = (size_t)(row0 + ai * 128 + m * 16) * ld + colbase + wc * 32 + 8 * fq;
#pragma unroll
                    for (int bj = 0; bj < 2; ++bj) {
                        f32x4 v0 = acc[ai][bj][m][0], v1 = acc[ai][bj][m][1];
                        const size_t o = ro + bj * 128;
                        if (mode == 2) {
#pragma unroll
                            for (int i = 0; i < 4; ++i) { v0[i] = v0[i] * sigmoidf_(v0[i]); v1[i] = v1[i] * sigmoidf_(v1[i]); }
                        } else if (mode == 3) {
#pragma unroll
                            for (int i = 0; i < 4; ++i) { v0[i] = sigmoidf_(v0[i]); v1[i] = sigmoidf_(v1[i]); }
                        } else if (mode >= 4) {
                            const u32x4 g = gq[m][bj];
                            v0[0] *= bf_lo(g.x); v0[1] *= bf_hi(g.x); v0[2] *= bf_lo(g.y); v0[3] *= bf_hi(g.y); v1[0] *= bf_lo(g.z); v1[1] *= bf_hi(g.z); v1[2] *= bf_lo(g.w); v1[3] *= bf_hi(g.w);
                            if (mode == 5) { const u32x4 y = yq[m][bj];
                                v0[0] += bf_lo(y.x); v0[1] += bf_hi(y.x); v0[2] += bf_lo(y.y); v0[3] += bf_hi(y.y); v1[0] += bf_lo(y.z); v1[1] += bf_hi(y.z); v1[2] += bf_lo(y.w); v1[3] += bf_hi(y.w); }
                        }
                        u32x4 w; w.x = cvt_pk_bf16(v0[0], v0[1]); w.y = cvt_pk_bf16(v0[2], v0[3]); w.z = cvt_pk_bf16(v1[0], v1[1]); w.w = cvt_pk_bf16(v1[2], v1[3]);
                        if (attl) *(u32x4*)(dst + att_row_off(row0 + ai * 128 + m * 16, (colbase >> 7) + bj) + wc * 32 + 8 * fq) = w; else *(u32x4*)(dst + o) = w;
                    }
                }
            }
        }
    }
};

__device__ __forceinline__ void transpose_tile(const float* __restrict__ W, int K, int N, bf16_t* __restrict__ Wt, int k0, int n0, bool ropeperm, LAS float* tile, const int tid0) {
    const int tid = tid0;
#pragma unroll
    for (int i = 0; i < 8; ++i) { const int idx = tid + 512 * i, r = idx >> 6, c = idx & 63; const int nphys = n0 + c, nlog = perm_logical(nphys, ropeperm);
        tile[r * 65 + c] = W[(size_t)(k0 + r) * N + nlog]; }
    __syncthreads();
#pragma unroll
    for (int i = 0; i < 4; ++i) { const int idx = tid + 512 * i, nn = idx >> 5, kk = (idx & 31) * 2;
        *(unsigned*)(Wt + (size_t)(n0 + nn) * K + k0 + kk) = cvt_pk_bf16(tile[kk * 65 + nn], tile[(kk + 1) * 65 + nn]); }
    __syncthreads();
}

__device__ __forceinline__ void phase_prep(const Params& p, LAS unsigned char* lds, const int tid0) {
    const int tid = tid0;
    LAS float* fl = (LAS float*)lds;
    constexpr int N_MOD = 96, N_TW = 16 * 152, N_TA = 8 * 16, N_TR = 16 * 16, N_TM = 16 * 16, N_TP = 16 * 32, N_KEY = 64, N_ROPE = 1024;
    constexpr int O_TW = N_MOD, O_TA = O_TW + N_TW, O_TR = O_TA + N_TA, O_TM = O_TR + N_TR, O_TP = O_TM + N_TM, O_KEY = O_TP + N_TP, O_ROPE = O_KEY + N_KEY, N_ALL = O_ROPE + N_ROPE;
    for (int item = blockIdx.x; item < N_ALL; item += gridDim.x) {
        if (item < O_TW) {
            LAS float* sc = fl;
            LAS float* red = fl + 4096;
            for (int i = tid; i < 4096; i += 512) { const float v = p.c[i]; sc[i] = v * sigmoidf_(v); }
            __syncthreads();
            const int col = item * 64 + (tid & 63), kg = tid >> 6;
            float a0 = 0.f, a1 = 0.f, a2 = 0.f, a3 = 0.f;
#pragma unroll 8
            for (int k = kg * 128; k < kg * 128 + 128; ++k) { const float w = p.w_ada[(size_t)k * 6144 + col]; a0 += sc[k] * w; a1 += sc[1024 + k] * w; a2 += sc[2048 + k] * w; a3 += sc[3072 + k] * w; }
            red[(kg * 4 + 0) * 64 + (tid & 63)] = a0; red[(kg * 4 + 1) * 64 + (tid & 63)] = a1; red[(kg * 4 + 2) * 64 + (tid & 63)] = a2; red[(kg * 4 + 3) * 64 + (tid & 63)] = a3;
            __syncthreads();
            if (tid < 256) { const int b = tid >> 6, cc = tid & 63; float s = 0.f;
#pragma unroll
                for (int g = 0; g < 8; ++g) s += red[(g * 4 + b) * 64 + cc];
                ((float*)(p.ws + WS_MOD))[b * 6144 + item * 64 + cc] = s + p.b_ada[item * 64 + cc]; }
            __syncthreads();
        } else if (item < O_TA) { const int t = item - O_TW, kt = t & 15, nt = t >> 4; const int n0 = nt * 64; const bool rp = (n0 < 3072) || (n0 >= 4608 && n0 < 5632);
            transpose_tile(p.w_in, 1024, IN_W, (bf16_t*)(p.ws + WS_WIN_T), kt * 64, n0, rp, fl, tid0);
        } else if (item < O_TR) { const int t = item - O_TA, kt = t & 7, nt = t >> 3; transpose_tile(p.w_att, 512, 1024, (bf16_t*)(p.ws + WS_WA_T), kt * 64, nt * 64, false, fl, tid0);
        } else if (item < O_TM) { const int t = item - O_TR, kt = t & 15, nt = t >> 4; transpose_tile(p.w_ret, 1024, 1024, (bf16_t*)(p.ws + WS_WR_T), kt * 64, nt * 64, false, fl, tid0);
        } else if (item < O_TP) { const int t = item - O_TM, kt = t & 15, nt = t >> 4; transpose_tile(p.w_mix, 1024, 1024, (bf16_t*)(p.ws + WS_WMX_T), kt * 64, nt * 64, false, fl, tid0);
        } else if (item < O_KEY) { const int t = item - O_TP, kt = t & 15, nt = t >> 4; transpose_tile(p.w_pq, 1024, 2048, (bf16_t*)(p.ws + WS_WPQ_T), kt * 64, nt * 64, false, fl, tid0);
        } else if (item < O_ROPE) { const int t = item - O_KEY;
            const float* src = t < 32 ? p.keys1 : p.keys2; const int base = (t & 31) * 4096 + tid * 8;
            const f32x4 a = *(const f32x4*)(src + base), b = *(const f32x4*)(src + base + 4);
            u32x4 w; w.x = cvt_pk_bf16(a[0], a[1]); w.y = cvt_pk_bf16(a[2], a[3]); w.z = cvt_pk_bf16(b[0], b[1]); w.w = cvt_pk_bf16(b[2], b[3]);
            *(u32x4*)((bf16_t*)(p.ws + WS_KEYS) + (size_t)(t >> 5) * 131072 + base) = w;
        } else { const int t = item - O_ROPE;
            float* rope = (float*)(p.ws + WS_ROPE);
#pragma unroll
            for (int i = 0; i < 4; ++i) { const int e = t * 2048 + i * 512 + tid, tok = e >> 6, dd = e & 63;
                const double inv = exp2(-(double)dd * (13.287712379549449 / 64.0));
                double rev = (double)p.pos[tok] * inv * 0.15915494309189535; rev -= rint(rev);
                const float rf = (float)rev;
                f32x2 cs; cs.x = __builtin_amdgcn_cosf(rf); cs.y = __builtin_amdgcn_sinf(rf);
                *(f32x2*)(rope + (size_t)e * 2) = cs; }
        }
    }
}

__device__ __forceinline__ void phase_h(const Params& p, const int tid0) {
    const int lane = tid0 & 63, w = tid0 >> 6;
    const float* mod = (const float*)(p.ws + WS_MOD);
    bf16_t* h = (bf16_t*)((unsigned char*)p.out + DO_H);
    const int stride = gridDim.x * 8;
    int row = blockIdx.x * 8 + w;
    f32x4 v[4], vn[4], pA[4], pB[4]; int curb = -1;
#define PH_LOAD(dst, r_) do { const int rr_ = (r_) < T ? (r_) : T - 1; _Pragma("unroll") for (int i_ = 0; i_ < 4; ++i_) dst[i_] = __builtin_nontemporal_load((const f32x4*)(p.x + (size_t)rr_ * DM + i_ * 256 + lane * 4)); } while (0)
    PH_LOAD(v, row);
    for (; row < T; row += stride) {
        PH_LOAD(vn, row + stride);
        const int b = row / SEQ;
        if (b != curb) {
            curb = b;
#pragma unroll
            for (int i = 0; i < 4; ++i) { const int c = i * 256 + lane * 4; const f32x4 g = *(const f32x4*)(p.g_pre_mix + c), sc = *(const f32x4*)(mod + b * 6144 + 1024 + c); pB[i] = *(const f32x4*)(mod + b * 6144 + c);
#pragma unroll
                for (int j = 0; j < 4; ++j) pA[i][j] = g[j] * (1.0f + sc[j]); }
        }
        float ss = 0.f;
#pragma unroll
        for (int i = 0; i < 4; ++i) ss += v[i][0] * v[i][0] + v[i][1] * v[i][1] + v[i][2] * v[i][2] + v[i][3] * v[i][3];
        ss = wave_sum(ss);
        const float rstd = rsqrtf(ss * (1.0f / DM) + NORM_EPS);
#pragma unroll
        for (int i = 0; i < 4; ++i) { const int c = i * 256 + lane * 4;
            float o[4];
#pragma unroll
            for (int j = 0; j < 4; ++j) o[j] = v[i][j] * rstd * pA[i][j] + pB[i][j];
            u32x2 wv; wv.x = cvt_pk_bf16(o[0], o[1]); wv.y = cvt_pk_bf16(o[2], o[3]);
            *(u32x2*)(h + (size_t)row * DM + c) = wv; }
#pragma unroll
        for (int i = 0; i < 4; ++i) v[i] = vn[i];
    }
#undef PH_LOAD
}

__device__ __forceinline__ void phase_attn(const Params& p, LAS unsigned char* lds, const int tid0) {
    const int tid = tid0, lane = tid & 63, w = tid >> 6, l15 = lane & 15, g4 = lane >> 4;
    LAS unsigned char* Ks = lds;
    LAS unsigned char* Vs = lds + 256 * 272;
    const bf16_t* aq = (const bf16_t*)(p.ws + WS_AQ); const bf16_t* ak = (const bf16_t*)(p.ws + WS_AK); const bf16_t* av = (const bf16_t*)(p.ws + WS_AV);
    bf16_t* og = (bf16_t*)(p.ws + WS_OG); float* lse = (float*)(p.ws + WS_LSE);
    u32x4 kst[8], vst[8]; bf16x8 qn[4];
#define AT_FETCH(item_) do { const int it_ = (item_) < 3072 ? (item_) : 3071; const int b_ = it_ / 768, rem_ = it_ - b_ * 768, h12_ = rem_ >> 6, qb_ = rem_ & 63, dsh_ = (h12_ >> 2) * 2, dil_ = 1 << dsh_, r_ = qb_ & (dil_ - 1), n_ = qb_ >> dsh_; \
        const size_t hb_ = (size_t)(b_ * 12 + h12_) * SEQ + ((size_t)r_ << (13 - dsh_));       \
          \
        _Pragma("unroll") for (int kk_ = 0; kk_ < 4; ++kk_) qn[kk_] = *(const bf16x8*)(aq + (hb_ + (size_t)(128 * n_ + 16 * w + l15)) * 128 + 32 * kk_ + 8 * g4); \
        _Pragma("unroll") for (int i_ = 0; i_ < 8; ++i_) { const int c_ = tid + 512 * i_, row_ = c_ >> 4, ch_ = c_ & 15; const int m_ = 128 * (n_ - 1) + row_; \
            const size_t off_ = (hb_ + (size_t)(m_ < 0 ? 0 : m_)) * 128 + ch_ * 8; const u32x4 kq_ = *(const u32x4*)(ak + off_), vq_ = *(const u32x4*)(av + off_); \
            kst[i_] = m_ >= 0 ? kq_ : (u32x4){0u, 0u, 0u, 0u}; vst[i_] = m_ >= 0 ? vq_ : (u32x4){0u, 0u, 0u, 0u}; } (void)dil_; } while (0)
    AT_FETCH(blockIdx.x);
    for (int item = blockIdx.x; item < 3072; item += gridDim.x) {
        const int b = item / 768, rem = item - b * 768, h12 = rem >> 6, qb = rem & 63, grp = h12 >> 2, hh = h12 & 3;
        const int dsh = grp * 2, dil = 1 << dsh, r = qb & (dil - 1), n = qb >> dsh;
        const size_t tb = (size_t)b * SEQ;
        const int i = 16 * w + l15;
        const size_t tq = tb + (size_t)(128 * n + i) * dil + r;
#pragma unroll
        for (int it = 0; it < 8; ++it) { const int c = tid + 512 * it, row = c >> 4, ch = c & 15; *(LAS u32x4*)(Ks + row * 272 + ch * 16) = kst[it]; *(LAS u32x4*)(Vs + row * 288 + ch * 16) = vst[it]; }
        bf16x8 qf[4];
#pragma unroll
        for (int kk = 0; kk < 4; ++kk) qf[kk] = qn[kk];
        asm volatile("" : "+v"(qf[0]), "+v"(qf[1]), "+v"(qf[2]), "+v"(qf[3]));
        __syncthreads();
        AT_FETCH(item + (int)gridDim.x);
        __builtin_amdgcn_sched_barrier(0);
        const int kt0 = w < 6 ? w : 6;
        f32x4 sacc[10];
        {
            bf16x8 ka[8], kb[8];
            const LAS unsigned char* kbase = Ks + (16 * kt0 + l15) * 272 + (8 * g4) * 2;
#define AT_KLD(dst, tp) do { _Pragma("unroll") for (int u_ = 0; u_ < 8; ++u_) dst[u_] = *(const LAS bf16x8*)(kbase + (2 * (tp) + (u_ >> 2)) * (16 * 272) + (u_ & 3) * 64); } while (0)
#define AT_KMM(src, tp) do { _Pragma("unroll") for (int h_ = 0; h_ < 2; ++h_) { f32x4 a4_ = {0.f, 0.f, 0.f, 0.f}; _Pragma("unroll") for (int kk_ = 0; kk_ < 4; ++kk_) a4_ = __builtin_amdgcn_mfma_f32_16x16x32_bf16(src[4 * h_ + kk_], qf[kk_], a4_, 0, 0, 0); sacc[2 * (tp) + h_] = a4_; } } while (0)
            AT_KLD(ka, 0); AT_KLD(kb, 1);
            __builtin_amdgcn_sched_barrier(0);
            AT_KMM(ka, 0); AT_KLD(ka, 2);
            __builtin_amdgcn_sched_barrier(0);
            AT_KMM(kb, 1); AT_KLD(kb, 3);
            __builtin_amdgcn_sched_barrier(0);
            AT_KMM(ka, 2); AT_KLD(ka, 4);
            __builtin_amdgcn_sched_barrier(0);
            AT_KMM(kb, 3);
            AT_KMM(ka, 4);
#undef AT_KLD
#undef AT_KMM
        }
        float mx = -1e30f;
#pragma unroll
        for (int t = 0; t < 10; ++t)
#pragma unroll
            for (int rg = 0; rg < 4; ++rg) { const int jj = 16 * (kt0 + t) + 4 * g4 + rg; const bool valid = (jj >= i) && (jj <= i + 128) && (n > 0 || jj >= 128);
                const float s = valid ? sacc[t][rg] : -1e30f; sacc[t][rg] = s; mx = fmaxf(mx, s); }
        mx = fmaxf(mx, __shfl_xor(mx, 16)); mx = fmaxf(mx, __shfl_xor(mx, 32));
        float sum = 0.f;
#pragma unroll
        for (int t = 0; t < 10; ++t)
#pragma unroll
            for (int rg = 0; rg < 4; ++rg) { const float e = fast_exp2(sacc[t][rg] - mx); sacc[t][rg] = e; sum += e; }
        sum += __shfl_xor(sum, 16); sum += __shfl_xor(sum, 32);
        f32x4 oacc[8];
#pragma unroll
        for (int et = 0; et < 8; ++et) oacc[et] = (f32x4){0.f, 0.f, 0.f, 0.f};
#pragma unroll
        for (int s5 = 0; s5 < 5; ++s5) {
            u32x4 pw; pw.x = cvt_pk_bf16(sacc[2 * s5][0], sacc[2 * s5][1]); pw.y = cvt_pk_bf16(sacc[2 * s5][2], sacc[2 * s5][3]);
            pw.z = cvt_pk_bf16(sacc[2 * s5 + 1][0], sacc[2 * s5 + 1][1]); pw.w = cvt_pk_bf16(sacc[2 * s5 + 1][2], sacc[2 * s5 + 1][3]);
            const bf16x8 pf = __builtin_bit_cast(bf16x8, pw);
            const LAS unsigned char* vb = Vs + (16 * (kt0 + 2 * s5) + 4 * g4 + (l15 >> 2)) * 288 + 16 * (l15 & 3);
#pragma unroll
            for (int et = 0; et < 8; ++et) { const s16x4 lo = lds_tr(vb + (et >> 1) * 64 + (et & 1) * 8), hi = lds_tr(vb + (et >> 1) * 64 + (et & 1) * 8 + 16 * 288);
                oacc[et] = __builtin_amdgcn_mfma_f32_16x16x32_bf16(cat8(lo, hi), pf, oacc[et], 0, 0, 0); }
        }
        const float inv = 1.0f / sum;
        bf16_t* op = og + (size_t)grp * T * 512 + tq * 512 + hh * 128 + 8 * g4;
#pragma unroll
        for (int u = 0; u < 4; ++u) { u32x4 wv; wv.x = cvt_pk_bf16(oacc[2 * u][0] * inv, oacc[2 * u][1] * inv); wv.y = cvt_pk_bf16(oacc[2 * u][2] * inv, oacc[2 * u][3] * inv);
            wv.z = cvt_pk_bf16(oacc[2 * u + 1][0] * inv, oacc[2 * u + 1][1] * inv); wv.w = cvt_pk_bf16(oacc[2 * u + 1][2] * inv, oacc[2 * u + 1][3] * inv); *(u32x4*)(op + u * 32) = wv; }
        if (g4 == 0) lse[(size_t)grp * T * 4 + tq * 4 + hh] = mx * 0.6931471805599453f + __logf(sum);
        __syncthreads();
    }
#undef AT_FETCH
}

__device__ __forceinline__ void phase_combine(const Params& p, const int tid0) {
    const bf16_t* og = (const bf16_t*)(p.ws + WS_OG); const float* lse = (const float*)(p.ws + WS_LSE);
    bf16_t* ya = (bf16_t*)((unsigned char*)p.out + DO_YATT);
    for (int idx = blockIdx.x * 512 + tid0; idx < T * 64; idx += gridDim.x * 512) {
        const int t = idx >> 6, c8 = idx & 63, hh = c8 >> 4;
        const float l0 = lse[(size_t)t * 4 + hh], l1 = lse[(size_t)T * 4 + (size_t)t * 4 + hh], l2 = lse[(size_t)T * 8 + (size_t)t * 4 + hh];
        const float m = fmaxf(l0, fmaxf(l1, l2)); float w0 = __expf(l0 - m), w1 = __expf(l1 - m), w2 = __expf(l2 - m); const float iv = 1.0f / (w0 + w1 + w2); w0 *= iv; w1 *= iv; w2 *= iv;
        const size_t o = (size_t)t * 512 + c8 * 8;
        const u32x4 a = *(const u32x4*)(og + o), bq = *(const u32x4*)(og + (size_t)T * 512 + o), cq = *(const u32x4*)(og + (size_t)T * 1024 + o);
        u32x4 r;
#pragma unroll
        for (int j = 0; j < 4; ++j) { const float lo = w0 * bf_lo(a[j]) + w1 * bf_lo(bq[j]) + w2 * bf_lo(cq[j]), hi = w0 * bf_hi(a[j]) + w1 * bf_hi(bq[j]) + w2 * bf_hi(cq[j]); r[j] = cvt_pk_bf16(lo, hi); }
        *(u32x4*)(ya + o) = r;
    }
}

__device__ __forceinline__ float ret_log2g(int h) { return __log2f(1.0f - fast_exp2(-5.0f - (float)h)); }

__device__ __forceinline__ void phase_kv(const Params& p, LAS unsigned char* lds, const int tid0) {
    const int tid = tid0, lane = tid & 63, w = tid >> 6, l15 = lane & 15, g4 = lane >> 4;
    LAS unsigned char* Ks = lds;
    LAS unsigned char* Vs = lds + 128 * 288;
    const bf16_t* rk = (const bf16_t*)(p.ws + WS_RK); const bf16_t* rv = (const bf16_t*)(p.ws + WS_RV);
    float* kv = (float*)(p.ws + WS_KV);
    for (int item = blockIdx.x; item < 1024; item += gridDim.x) {
        const int n = item & 63, bh = item >> 6, h = bh & 3, b = bh >> 2;
        const size_t tok0 = (size_t)b * SEQ + 128 * n;
        const float lg = ret_log2g(h);
#pragma unroll
        for (int it = 0; it < 4; ++it) { const int c = tid + 512 * it, j = c >> 4, ch = c & 15;
            const u32x4 q = *(const u32x4*)(rk + (tok0 + j) * RET_QK_W + h * 128 + ch * 8); const float z = fast_exp2((float)(127 - j) * lg);
            u32x4 o;
#pragma unroll
            for (int e = 0; e < 4; ++e) o[e] = cvt_pk_bf16(bf_lo(q[e]) * z, bf_hi(q[e]) * z);
            *(LAS u32x4*)(Ks + j * 288 + ch * 16) = o; }
#pragma unroll
        for (int it = 0; it < 8; ++it) { const int c = tid + 512 * it, j = c >> 5, ch = c & 31;
            *(LAS u32x4*)(Vs + j * 544 + ch * 16) = *(const u32x4*)(rv + (tok0 + j) * RET_V_W + h * 256 + ch * 8); }
        __syncthreads();
        f32x4 acc[2][8];
#pragma unroll
        for (int a = 0; a < 2; ++a)
#pragma unroll
            for (int d = 0; d < 8; ++d) acc[a][d] = (f32x4){0.f, 0.f, 0.f, 0.f};
#pragma unroll
        for (int kk = 0; kk < 4; ++kk) {
            const int rowb = 32 * kk + 4 * g4 + (l15 >> 2), colb = (4 * (l15 & 3)) * 2;
            bf16x8 af[2];
#pragma unroll
            for (int a = 0; a < 2; ++a) { const LAS unsigned char* vb = Vs + rowb * 544 + (2 * w + a) * 32 + colb; af[a] = cat8(lds_tr(vb), lds_tr(vb + 16 * 544)); }
#pragma unroll
            for (int d = 0; d < 8; ++d) { const LAS unsigned char* kb = Ks + rowb * 288 + d * 32 + colb; const bf16x8 bfr = cat8(lds_tr(kb), lds_tr(kb + 16 * 288));
#pragma unroll
                for (int a = 0; a < 2; ++a) acc[a][d] = __builtin_amdgcn_mfma_f32_16x16x32_bf16(bfr, af[a], acc[a][d], 0, 0, 0); }
        }
        float* dst = kv + (size_t)item * 32768;
#pragma unroll
        for (int a = 0; a < 2; ++a)
#pragma unroll
            for (int d = 0; d < 8; ++d)
                *(f32x4*)(dst + (16 * (2 * w + a) + l15) * 128 + 16 * d + 4 * g4) = acc[a][d];
        __syncthreads();
    }
}

__device__ __forceinline__ void phase_scan(const Params& p, const int tid0) {
    const float* __restrict__ kv = (const float*)(p.ws + WS_KV);
    bf16_t* __restrict__ rprev = (bf16_t*)((unsigned char*)p.out + DO_RPREV);
    for (int idx = blockIdx.x * 512 + tid0; idx < 16 * 8192; idx += gridDim.x * 512) {
        const int bh = idx >> 13, within = idx & 8191, h = bh & 3;
        const float gd = fast_exp2(128.0f * ret_log2g(h));
        f32x4 st = {0.f, 0.f, 0.f, 0.f};
        const size_t base = (size_t)bh * 64 * 32768 + (size_t)within * 4;
#pragma unroll 8
        for (int n = 0; n < 64; ++n) {
            u32x2 wv; wv.x = cvt_pk_bf16(st[0], st[1]); wv.y = cvt_pk_bf16(st[2], st[3]);
            *(u32x2*)(rprev + base + (size_t)n * 32768) = wv;
            const f32x4 k4 = *(const f32x4*)(kv + base + (size_t)n * 32768);
            st = st * gd + k4;
        }
    }
}

__device__ __forceinline__ void phase_ret(const Params& p, LAS unsigned char* lds, const int tid0) {
    const int tid = tid0, lane = tid & 63, w = __builtin_amdgcn_readfirstlane(tid >> 6), l15 = lane & 15, g4 = lane >> 4;
    LAS unsigned char* Ks = lds;
    LAS unsigned char* Bs = lds + 128 * 272;
    const bf16_t* rq = (const bf16_t*)(p.ws + WS_RQ); const bf16_t* rk = (const bf16_t*)(p.ws + WS_RK); const bf16_t* rv = (const bf16_t*)(p.ws + WS_RV); const bf16_t* srg = (const bf16_t*)(p.ws + WS_RG);
    const bf16_t* rprev = (const bf16_t*)((const unsigned char*)p.out + DO_RPREV);
    bf16_t* ro = (bf16_t*)(p.ws + WS_RO);
    u32x4 kst[4], rst[8], vst[8];
#define RT_FETCH_KR(item_) do { const int it_ = (item_) < 1024 ? (item_) : 1023; const int n_ = it_ & 63, bh_ = it_ >> 6, h_ = bh_ & 3, b_ = bh_ >> 2; const size_t tk_ = (size_t)b_ * SEQ + 128 * n_; \
        _Pragma("unroll") for (int i_ = 0; i_ < 4; ++i_) { const int c_ = tid + 512 * i_, j_ = c_ >> 4, ch_ = c_ & 15; kst[i_] = *(const u32x4*)(rk + (tk_ + j_) * RET_QK_W + h_ * 128 + ch_ * 8); } \
        _Pragma("unroll") for (int i_ = 0; i_ < 8; ++i_) { const int c_ = tid + 512 * i_; rst[i_] = *(const u32x4*)(rprev + (size_t)it_ * 32768 + (size_t)c_ * 8); } } while (0)
    RT_FETCH_KR(blockIdx.x);
    for (int item = blockIdx.x; item < 1024; item += gridDim.x) {
        const int n = item & 63, bh = item >> 6, h = bh & 3, b = bh >> 2;
        const size_t tok0 = (size_t)b * SEQ + 128 * n;
        const float lg = ret_log2g(h);
#pragma unroll
        for (int it = 0; it < 4; ++it) { const int c = tid + 512 * it, j = c >> 4, ch = c & 15; *(LAS u32x4*)(Ks + j * 272 + ch * 16) = kst[it]; }
#pragma unroll
        for (int it = 0; it < 8; ++it) { const int c = tid + 512 * it, e = c >> 4, ch = c & 15; *(LAS u32x4*)(Bs + e * 272 + ch * 16) = rst[it]; }
#pragma unroll
        for (int it = 0; it < 8; ++it) { const int c = tid + 512 * it, j = c >> 5, ch = c & 31; vst[it] = *(const u32x4*)(rv + (tok0 + j) * RET_V_W + h * 256 + ch * 8); }
        const int i = 16 * w + l15; const size_t tq = tok0 + i;
        bf16x8 qf[4];
#pragma unroll
        for (int kk = 0; kk < 4; ++kk) qf[kk] = *(const bf16x8*)(rq + tq * RET_QK_W + h * 128 + 32 * kk + 8 * g4);
        __syncthreads();
        f32x4 acc[16];
#pragma unroll
        for (int et = 0; et < 16; ++et) acc[et] = (f32x4){0.f, 0.f, 0.f, 0.f};
        {
            const LAS unsigned char* rb = Bs + (8 * (l15 >> 2) + (l15 & 3)) * 272 + (8 * g4) * 2;
            bf16x8 ra[8], rbf[8];
#define RT_LD(dst, bt) do { _Pragma("unroll") for (int u_ = 0; u_ < 8; ++u_) dst[u_] = *(const LAS bf16x8*)(rb + (bt) * (32 * 272) + (u_ >> 2) * (4 * 272) + (u_ & 3) * 64); } while (0)
#define RT_MM(src, bt) do { _Pragma("unroll") for (int u_ = 0; u_ < 8; ++u_) acc[2 * (bt) + (u_ >> 2)] = __builtin_amdgcn_mfma_f32_16x16x32_bf16(src[u_], qf[u_ & 3], acc[2 * (bt) + (u_ >> 2)], 0, 0, 0); } while (0)
            RT_LD(ra, 0); RT_LD(rbf, 1);
#pragma unroll
            for (int bt = 0; bt < 8; bt += 2) {
                __builtin_amdgcn_sched_barrier(0);
                RT_MM(ra, bt); if (bt + 2 < 8) RT_LD(ra, bt + 2);
                __builtin_amdgcn_sched_barrier(0);
                RT_MM(rbf, bt + 1); if (bt + 3 < 8) RT_LD(rbf, bt + 3);
            }
#undef RT_LD
#undef RT_MM
        }
        const float xi = fast_exp2((float)(i + 1) * lg);
#pragma unroll
        for (int et = 0; et < 16; ++et) acc[et] = acc[et] * xi;
        bf16x8 pf[4];
#pragma unroll
        for (int s4 = 0; s4 < 4; ++s4) {
            u32x4 pw = {0u, 0u, 0u, 0u};
            if (2 * s4 <= w) {
                float pv[2][4];
#pragma unroll
                for (int u = 0; u < 2; ++u) { const int kt = 2 * s4 + u; f32x4 a4 = {0.f, 0.f, 0.f, 0.f};
#pragma unroll
                    for (int kk = 0; kk < 4; ++kk) { const bf16x8 kf = *(const LAS bf16x8*)(Ks + (16 * kt + l15) * 272 + (32 * kk + 8 * g4) * 2); a4 = __builtin_amdgcn_mfma_f32_16x16x32_bf16(kf, qf[kk], a4, 0, 0, 0); }
#pragma unroll
                    for (int rg = 0; rg < 4; ++rg) { const int j = 16 * kt + 4 * g4 + rg; pv[u][rg] = (j <= i) ? a4[rg] * fast_exp2((float)(i - j) * lg) : 0.f; } }
                pw.x = cvt_pk_bf16(pv[0][0], pv[0][1]); pw.y = cvt_pk_bf16(pv[0][2], pv[0][3]); pw.z = cvt_pk_bf16(pv[1][0], pv[1][1]); pw.w = cvt_pk_bf16(pv[1][2], pv[1][3]);
            }
            pf[s4] = __builtin_bit_cast(bf16x8, pw);
        }
        __syncthreads();
#pragma unroll
        for (int it = 0; it < 8; ++it) { const int c = tid + 512 * it, j = c >> 5, ch = c & 31; *(LAS u32x4*)(Bs + j * 544 + ch * 16) = vst[it]; }
        RT_FETCH_KR(item + (int)gridDim.x);
        __builtin_amdgcn_sched_barrier(0);
        __syncthreads();
#pragma unroll
        for (int s4 = 0; s4 < 4; ++s4) {
            if (2 * s4 <= w) {
                const LAS unsigned char* vb = Bs + (32 * s4 + 4 * g4 + (l15 >> 2)) * 544 + 16 * (l15 & 3);
#pragma unroll
                for (int et = 0; et < 16; ++et) { const s16x4 lo = lds_tr(vb + (et >> 1) * 64 + (et & 1) * 8), hi = lds_tr(vb + (et >> 1) * 64 + (et & 1) * 8 + 16 * 544);
                    acc[et] = __builtin_amdgcn_mfma_f32_16x16x32_bf16(cat8(lo, hi), pf[s4], acc[et], 0, 0, 0); }
            }
        }
        float ss = 0.f;
#pragma unroll
        for (int et = 0; et < 16; ++et) ss += acc[et][0] * acc[et][0] + acc[et][1] * acc[et][1] + acc[et][2] * acc[et][2] + acc[et][3] * acc[et][3];
        ss += __shfl_xor(ss, 16); ss += __shfl_xor(ss, 32);
        const float rstd = rsqrtf(ss * (1.0f / 256.0f) + NORM_EPS);
        u32x4 gq[8];
#pragma unroll
        for (int u = 0; u < 8; ++u) gq[u] = *(const u32x4*)(srg + tq * RET_V_W + h * 256 + 32 * u + 8 * g4);
#pragma unroll
        for (int u = 0; u < 8; ++u) { const size_t o = tq * RET_V_W + h * 256 + 32 * u + 8 * g4; const f32x4 a0 = acc[2 * u], a1 = acc[2 * u + 1]; const u32x4 g = gq[u];
            u32x4 wv; wv.x = cvt_pk_bf16(a0[0] * rstd * bf_lo(g.x), a0[1] * rstd * bf_hi(g.x)); wv.y = cvt_pk_bf16(a0[2] * rstd * bf_lo(g.y), a0[3] * rstd * bf_hi(g.y));
            wv.z = cvt_pk_bf16(a1[0] * rstd * bf_lo(g.z), a1[1] * rstd * bf_hi(g.z)); wv.w = cvt_pk_bf16(a1[2] * rstd * bf_lo(g.w), a1[3] * rstd * bf_hi(g.w));
            *(u32x4*)(ro + o) = wv; }
        __syncthreads();
    }
#undef RT_FETCH_KR
}


__device__ __forceinline__ float wave_max(float v) { v = row16_max_f(v); v = fmaxf(v, __shfl_xor(v, 16)); v = fmaxf(v, __shfl_xor(v, 32)); return v; }
__device__ __forceinline__ unsigned pack_i8x4(float a, float b, float c, float d) {
    const int ia = (int)__builtin_rintf(a), ib = (int)__builtin_rintf(b), ic = (int)__builtin_rintf(c), id = (int)__builtin_rintf(d);
    return (unsigned)(ia & 0xff) | ((unsigned)(ib & 0xff) << 8) | ((unsigned)(ic & 0xff) << 16) | ((unsigned)(id & 0xff) << 24);
}
__device__ __forceinline__ void phase_rows(const Params& p, const int tid0) {
    const int lane = tid0 & 63, w = tid0 >> 6;
    const float* mod = (const float*)(p.ws + WS_MOD); const bf16_t* ym = (const bf16_t*)(p.ws + WS_YM);
    bf16_t* h2 = (bf16_t*)(p.ws + WS_H2); unsigned char* h2q = p.ws + WS_H2Q; float* sx = (float*)(p.ws + WS_SX); bf16_t* x1b = (bf16_t*)(p.ws + WS_X1B);
    const int rstride = gridDim.x * 8;
    u32x2 yq[4], yqn[4]; f32x4 xq[4], xqn[4]; f32x4 pG1[4], pA2[4], pB2[4]; int curb = -1;
#define PR_LOAD(yd, xd, r_) do { const int rr_ = (r_) < T ? (r_) : T - 1; _Pragma("unroll") for (int i_ = 0; i_ < 4; ++i_) { yd[i_] = __builtin_nontemporal_load((const u32x2*)(ym + (size_t)rr_ * DM + i_ * 256 + lane * 4)); xd[i_] = __builtin_nontemporal_load((const f32x4*)(p.x + (size_t)rr_ * DM + i_ * 256 + lane * 4)); } } while (0)
    PR_LOAD(yq, xq, blockIdx.x * 8 + w);
    for (int row = blockIdx.x * 8 + w; row < T; row += rstride) {
        PR_LOAD(yqn, xqn, row + rstride);
        const int b = row / SEQ;
        if (b != curb) {
            curb = b; const float* mb = mod + b * 6144;
#pragma unroll
            for (int i = 0; i < 4; ++i) { const int c = i * 256 + lane * 4;
                const f32x4 g1 = *(const f32x4*)(p.g_post_mix + c), gt = *(const f32x4*)(mb + 2048 + c), g2 = *(const f32x4*)(p.g_pre_ffn + c), sc = *(const f32x4*)(mb + 4096 + c); pB2[i] = *(const f32x4*)(mb + 3072 + c);
#pragma unroll
                for (int j = 0; j < 4; ++j) { pG1[i][j] = g1[j] * gt[j]; pA2[i][j] = g2[j] * (1.0f + sc[j]); } }
        }
        f32x4 v[4]; float ss = 0.f;
#pragma unroll
        for (int i = 0; i < 4; ++i) { const u32x2 q = yq[i]; v[i] = (f32x4){bf_lo(q.x), bf_hi(q.x), bf_lo(q.y), bf_hi(q.y)}; ss += v[i][0] * v[i][0] + v[i][1] * v[i][1] + v[i][2] * v[i][2] + v[i][3] * v[i][3]; }
        ss = wave_sum(ss);
        const float rstd = rsqrtf(ss * (1.0f / DM) + NORM_EPS);
        float s1 = 0.f;
#pragma unroll
        for (int i = 0; i < 4; ++i) { const int c = i * 256 + lane * 4;
            const f32x4 xv = xq[i];
#pragma unroll
            for (int j = 0; j < 4; ++j) { v[i][j] = xv[j] + pG1[i][j] * (v[i][j] * rstd); s1 += v[i][j] * v[i][j]; }
            u32x2 xw; xw.x = cvt_pk_bf16(v[i][0], v[i][1]); xw.y = cvt_pk_bf16(v[i][2], v[i][3]); *(u32x2*)(x1b + (size_t)row * DM + c) = xw; }
        s1 = wave_sum(s1);
        const float rstd1 = rsqrtf(s1 * (1.0f / DM) + NORM_EPS);
        float amax = 0.f;
#pragma unroll
        for (int i = 0; i < 4; ++i) { const int c = i * 256 + lane * 4;
#pragma unroll
            for (int j = 0; j < 4; ++j) { v[i][j] = v[i][j] * rstd1 * pA2[i][j] + pB2[i][j]; amax = fmaxf(amax, fabsf(v[i][j])); }
            u32x2 wv; wv.x = cvt_pk_bf16(v[i][0], v[i][1]); wv.y = cvt_pk_bf16(v[i][2], v[i][3]);
            *(u32x2*)(h2 + (size_t)row * DM + c) = wv; }
        amax = wave_max(amax);
        const float qs = amax > 0.f ? 127.0f / amax : 0.f;
#pragma unroll
        for (int i = 0; i < 4; ++i) *(unsigned*)(h2q + (size_t)row * DM + i * 256 + lane * 4) = pack_i8x4(v[i][0] * qs, v[i][1] * qs, v[i][2] * qs, v[i][3] * qs);
        if (lane == 0) sx[row] = amax * (1.0f / 127.0f);
#pragma unroll
        for (int i = 0; i < 4; ++i) { yq[i] = yqn[i]; xq[i] = xqn[i]; }
    }
#undef PR_LOAD
    unsigned char* dn = p.ws + WS_DN; unsigned char* up = p.ws + WS_UP; float* sdn = (float*)(p.ws + WS_SDN); float* sup = (float*)(p.ws + WS_SUP);
    {
        f32x4 ta[4], tb[4];
#define TQ_LOAD(dst, r_) do { const int rr_ = (r_) < 32768 ? (r_) : 32767; const float* src_ = (rr_ >= 16384 ? p.up + (size_t)(rr_ - 16384) * DM : p.down + (size_t)rr_ * DM); \
            _Pragma("unroll") for (int i_ = 0; i_ < 4; ++i_) dst[i_] = __builtin_nontemporal_load((const f32x4*)(src_ + i_ * 256 + lane * 4)); } while (0)
#define TQ_ROW(v, r_) do { if ((r_) < 32768) { const bool second_ = (r_) >= 16384; const int row_ = second_ ? (r_) - 16384 : (r_); float amax_ = 0.f; \
            _Pragma("unroll") for (int i_ = 0; i_ < 4; ++i_) amax_ = fmaxf(amax_, fmaxf(fmaxf(fabsf(v[i_][0]), fabsf(v[i_][1])), fmaxf(fabsf(v[i_][2]), fabsf(v[i_][3])))); \
            amax_ = wave_max(amax_); const float qs_ = amax_ > 0.f ? 127.0f / amax_ : 0.f; \
            _Pragma("unroll") for (int i_ = 0; i_ < 4; ++i_) { const unsigned pk_ = pack_i8x4(v[i_][0] * qs_, v[i_][1] * qs_, v[i_][2] * qs_, v[i_][3] * qs_); const int c_ = i_ * 256 + lane * 4; \
                if (second_) *(unsigned*)(up + (size_t)(c_ >> 7) * 2097152 + (size_t)row_ * 128 + (c_ & 127)) = pk_; else *(unsigned*)(dn + (size_t)row_ * DM + c_) = pk_; } \
            if (lane == 0) (second_ ? sup : sdn)[row_] = amax_ * (1.0f / 127.0f); } } while (0)
        const int tstr = gridDim.x * 8, tfirst = blockIdx.x * 8 + w;
        TQ_LOAD(ta, tfirst);
        for (int r = tfirst; r < 32768; r += 2 * tstr) {
            TQ_LOAD(tb, r + tstr);
            TQ_ROW(ta, r);
            TQ_LOAD(ta, r + 2 * tstr);
            TQ_ROW(tb, r + tstr);
        }
#undef TQ_LOAD
#undef TQ_ROW
    }
}

__device__ __forceinline__ unsigned f2key(float f) { const unsigned u = __float_as_uint(f); return u ^ ((unsigned)((int)u >> 31) | 0x80000000u); }
__device__ __forceinline__ float key2f(unsigned k) { return __uint_as_float((k & 0x80000000u) ? (k ^ 0x80000000u) : ~k); }
#define RT_CS(a, b) do { const unsigned _h = (a) > (b) ? (a) : (b), _l = (a) > (b) ? (b) : (a); (a) = _h; (b) = _l; } while (0)
__device__ __forceinline__ void bmerge16(unsigned (&v)[16]) {
#pragma unroll
    for (int j = 8; j >= 1; j >>= 1)
#pragma unroll
        for (int i = 0; i < 16; ++i) { const int l = i ^ j; if (l > i) RT_CS(v[i], v[l]); }
}
__device__ __forceinline__ void bsort16(unsigned (&v)[16]) {
#pragma unroll
    for (int k = 2; k <= 16; k <<= 1)
#pragma unroll
        for (int j = k >> 1; j >= 1; j >>= 1)
#pragma unroll
            for (int i = 0; i < 16; ++i) { const int l = i ^ j; if (l > i) { if ((i & k) == 0) RT_CS(v[i], v[l]); else RT_CS(v[l], v[i]); } }
}
__device__ __forceinline__ void topmerge16(unsigned (&a)[16], const unsigned (&b)[16]) {
#pragma unroll
    for (int i = 0; i < 16; ++i) a[i] = a[i] > b[15 - i] ? a[i] : b[15 - i];
    bmerge16(a);
}

__device__ __forceinline__ void phase_route(const Params& p, LAS unsigned char* lds, const int tid0) {
    const int tid = tid0, lane = tid & 63, w = tid >> 6, l15 = lane & 15, g4 = lane >> 4;
    const bf16_t* qp = (const bf16_t*)(p.ws + WS_QP); const bf16_t* keys = (const bf16_t*)(p.ws + WS_KEYS);
    int* ids = (int*)(p.ws + WS_IDS); float* gates = (float*)(p.ws + WS_GT);
    LAS unsigned* tab = (LAS unsigned*)lds + w * 512;
    LAS unsigned char* kls = lds + 16384;
    for (int blk = blockIdx.x; blk < T / 128; blk += gridDim.x) {
        const int tok = blk * 128 + w * 16 + l15;
        u32x4 kst[8]; bf16x8 qn[2][4];
#define RT_KLOAD(h_) do { _Pragma("unroll") for (int i_ = 0; i_ < 8; ++i_) { const int c_ = tid + 512 * i_; kst[i_] = *(const u32x4*)(keys + (size_t)(c_ >> 11) * 131072 + (size_t)(h_) * 16384 + (size_t)(c_ & 2047) * 8); } } while (0)
#define RT_KSTORE() do { _Pragma("unroll") for (int i_ = 0; i_ < 8; ++i_) { const int c_ = tid + 512 * i_; *(LAS u32x4*)(kls + (c_ >> 11) * 34816 + ((c_ >> 4) & 127) * 272 + (c_ & 15) * 16) = kst[i_]; } } while (0)
#define RT_QLOAD(h_) do { _Pragma("unroll") for (int hf_ = 0; hf_ < 2; ++hf_) _Pragma("unroll") for (int kk_ = 0; kk_ < 4; ++kk_) qn[hf_][kk_] = *(const bf16x8*)(qp + (size_t)tok * 2048 + (h_) * 256 + hf_ * 128 + 32 * kk_ + 8 * g4); } while (0)
        RT_KLOAD(0); RT_QLOAD(0);
        __syncthreads();
        RT_KSTORE();
#pragma unroll 1
        for (int h = 0; h < 8; ++h) {
            bf16x8 qf[2][4];
#pragma unroll
            for (int hf = 0; hf < 2; ++hf)
#pragma unroll
                for (int kk = 0; kk < 4; ++kk) qf[hf][kk] = qn[hf][kk];
            __syncthreads();
            if (h + 1 < 8) { RT_KLOAD(h + 1); RT_QLOAD(h + 1); }
            unsigned vp[2][16];
#pragma unroll
            for (int half = 0; half < 2; ++half) {
                unsigned ta[16], tb[16];
#pragma unroll
                for (int nt = 0; nt < 8; ++nt) { f32x4 a4 = {0.f, 0.f, 0.f, 0.f};
#pragma unroll
                    for (int kk = 0; kk < 4; ++kk) { const bf16x8 kf = *(const LAS bf16x8*)(kls + half * 34816 + (16 * nt + l15) * 272 + (32 * kk + 8 * g4) * 2); a4 = __builtin_amdgcn_mfma_f32_16x16x32_bf16(kf, qf[half][kk], a4, 0, 0, 0); }
#pragma unroll
                    for (int rg = 0; rg < 4; ++rg) { const unsigned k = (f2key(a4[rg]) & ~0x7Fu) | (unsigned)(16 * nt + 4 * g4 + rg); if (nt < 4) ta[4 * nt + rg] = k; else tb[4 * (nt - 4) + rg] = k; } }
                bsort16(ta); bsort16(tb); topmerge16(ta, tb);
#pragma unroll
                for (int rnd = 16; rnd <= 32; rnd <<= 1) {
#pragma unroll
                    for (int j = 0; j < 16; ++j) tb[j] = (unsigned)__shfl_xor((int)ta[j], rnd);
                    topmerge16(ta, tb); }
#pragma unroll
                for (int j = 0; j < 16; ++j) vp[half][j] = ta[j];
            }
            float f1[16], f2[16];
#pragma unroll
            for (int j = 0; j < 16; ++j) { f1[j] = key2f(vp[0][j] & ~0x7Fu); f2[j] = key2f(vp[1][j] & ~0x7Fu); }
#define RT_CK(a, b) ((f2key(f1[a] + f2[b]) & ~0xFFu) | (unsigned)(255 - (16 * (a) + (b))))
            unsigned top[16], l1[16];
#pragma unroll
            for (int b = 0; b < 16; ++b) top[b] = RT_CK(0, b);
#pragma unroll
            for (int b = 0; b < 8; ++b) { l1[b] = RT_CK(1, b); l1[15 - b] = RT_CK(8 + b, 0); }
            bmerge16(l1); topmerge16(top, l1);
            l1[0] = RT_CK(2, 0); l1[1] = RT_CK(2, 1); l1[2] = RT_CK(2, 2); l1[3] = RT_CK(2, 3); l1[4] = RT_CK(2, 4); l1[5] = RT_CK(3, 0); l1[6] = RT_CK(3, 1); l1[7] = RT_CK(3, 2); l1[8] = RT_CK(3, 3);
            l1[9] = RT_CK(4, 0); l1[10] = RT_CK(4, 1); l1[11] = RT_CK(4, 2); l1[12] = RT_CK(5, 0); l1[13] = RT_CK(5, 1); l1[14] = RT_CK(6, 0); l1[15] = RT_CK(6, 1);
            bsort16(l1); topmerge16(top, l1);
            { const unsigned c0 = RT_CK(7, 0), c1 = RT_CK(7, 1);
              top[15] = top[15] > c0 ? top[15] : c0; top[14] = top[14] > c1 ? top[14] : c1; bmerge16(top); }
#undef RT_CK
            const float m = key2f(top[0]); float e[16], se = 0.f;
#pragma unroll
            for (int j = 0; j < 16; ++j) { e[j] = __expf(key2f(top[j]) - m); se += e[j]; }
            const float ise = 1.0f / se;
            __syncthreads();
            if (h + 1 < 8) RT_KSTORE();
            if (g4 == 0) {
#pragma unroll
                for (int j = 0; j < 16; ++j) { tab[l15 * 32 + j] = vp[0][j]; tab[l15 * 32 + 16 + j] = vp[1][j]; } }
            __builtin_amdgcn_fence(__ATOMIC_RELEASE, "workgroup"); __builtin_amdgcn_wave_barrier(); __builtin_amdgcn_fence(__ATOMIC_ACQUIRE, "workgroup");
#pragma unroll
            for (int jj = 0; jj < 4; ++jj) {
                const unsigned k = g4 == 0 ? top[jj] : g4 == 1 ? top[4 + jj] : g4 == 2 ? top[8 + jj] : top[12 + jj];
                const float gt = (g4 == 0 ? e[jj] : g4 == 1 ? e[4 + jj] : g4 == 2 ? e[8 + jj] : e[12 + jj]) * ise;
                const unsigned ab = 255u - (k & 255u); const int a = (int)(ab >> 4), b = (int)(ab & 15u);
                const int i1 = tab[l15 * 32 + a] & 0x7F, i2 = tab[l15 * 32 + 16 + b] & 0x7F;
                ids[(size_t)tok * 128 + h * 16 + 4 * g4 + jj] = i1 * 128 + i2;
                gates[(size_t)tok * 128 + h * 16 + 4 * g4 + jj] = gt;
            }
        }
    }
}

#undef RT_KLOAD
#undef RT_KSTORE
#undef RT_QLOAD
constexpr float DN_SCALE = 128.0f, UP_SCALE = 8.0f;
__device__ __forceinline__ float gelu_erf(float v) {
    const float av = fabsf(v), t = __builtin_amdgcn_rcpf(av * 0.2316418882f + 1.0f);
    float q = t * 0.5307027145f + (-0.7265760135f); q = q * t + 0.7107068705f; q = q * t + (-0.142248368f); q = q * t + 0.127414796f; q = q * t;
    const float e = __builtin_amdgcn_exp2f((v * v) * (-0.72134752044f));
    const float m = v * (q * e);
    return v < 0.f ? m : v - m;
}
__device__ __forceinline__ f32x2 fp8lo(unsigned w) { return __builtin_amdgcn_cvt_pk_f32_fp8((int)w, false); }
__device__ __forceinline__ f32x2 fp8hi(unsigned w) { return __builtin_amdgcn_cvt_pk_f32_fp8((int)w, true); }
struct SliceInfo { int rank, nloc, sidx, nx; };

template <int MODE> __device__ __forceinline__ void phase_xdown(const Params& p, LAS unsigned char* lds, const int tid0, const SliceInfo si) {
    const int lane = tid0 & 63, w = tid0 >> 6, l15 = lane & 15, r4 = lane >> 4;
    const unsigned char* h2q = p.ws + WS_H2Q; const float* sx = (const float*)(p.ws + WS_SX); const unsigned char* dn = p.ws + WS_DN;
    const float* sdn = (const float*)(p.ws + WS_SDN); const float* sup = (const float*)(p.ws + WS_SUP);
    const int* ids = (const int*)(p.ws + WS_IDS); const float* gates = (const float*)(p.ws + WS_GT); float* wout = (float*)(p.ws + WS_WB);
    LAS int* lstb = (LAS int*)lds + w * 1024;
    const int t0 = si.rank * 8 + w, tstride = si.nloc * 8;
    const int K = t0 < T ? (T - 1 - t0) / tstride + 1 : 0;
    for (int sl = si.sidx; sl < 8; sl += si.nx) {
        if (K == 0) continue;
        int rawI[4]; u32x4 xC[4], xN[4]; u32x4 bufA[4], bufB[4]; float sxC, sxN;
        int nC = 0, nN = 0;
        float fin_g = 0.f, fin_sd = 0.f, fin_su = 0.f, fin_sx = 0.f; int fin_slot = 0, fin_dot = 0, fin_n = 0, fin_tok = 0;
#define XD_TOK(k_) (t0 + ((k_) < K ? (k_) : K - 1) * tstride)
#define XD_LOADI(k_) do { const size_t o_ = (size_t)XD_TOK(k_) * 128; rawI[0] = *(ids + o_ + lane); rawI[1] = *(ids + o_ + 64 + lane); \
            rawI[2] = (int)__float_as_uint(*(gates + o_ + lane)); rawI[3] = (int)__float_as_uint(*(gates + o_ + 64 + lane)); } while (0)
#define XD_LOADX(xx, sxx, k_) do { const int tk_ = XD_TOK(k_); const unsigned char* hp_ = h2q + (size_t)tk_ * DM + l15 * 16; _Pragma("unroll") for (int j_ = 0; j_ < 4; ++j_) xx[j_] = *((const u32x4*)(hp_ + j_ * 256)); sxx = sx[tk_]; } while (0)
#define XD_LIST(slot_, nout_) do { LAS int* l_ = lstb + (slot_) * 512; const bool inA_ = (rawI[0] >> 11) == sl, inB_ = (rawI[1] >> 11) == sl; \
            const unsigned long long mA_ = __ballot(inA_), mB_ = __ballot(inB_); const int nA_ = __popcll(mA_); nout_ = nA_ + __popcll(mB_); \
            const int rkA_ = __builtin_amdgcn_mbcnt_hi((unsigned)(mA_ >> 32), __builtin_amdgcn_mbcnt_lo((unsigned)mA_, 0u)); \
            const int rkB_ = nA_ + __builtin_amdgcn_mbcnt_hi((unsigned)(mB_ >> 32), __builtin_amdgcn_mbcnt_lo((unsigned)mB_, 0u)); \
            if (inA_) { l_[rkA_ * 4 + 0] = rawI[0]; l_[rkA_ * 4 + 1] = rawI[2]; l_[rkA_ * 4 + 2] = lane; } \
            if (inB_) { l_[rkB_ * 4 + 0] = rawI[1]; l_[rkB_ * 4 + 1] = rawI[3]; l_[rkB_ * 4 + 2] = 64 + lane; } \
            __builtin_amdgcn_fence(__ATOMIC_RELEASE, "wavefront"); __builtin_amdgcn_wave_barrier(); __builtin_amdgcn_fence(__ATOMIC_ACQUIRE, "wavefront"); } while (0)
#define XD_ISSUE(dd, slot_, n_, g_) do { const LAS int* l_ = lstb + (slot_) * 512; const int k_ = 4 * (g_) + r4; const int id_ = (MODE != 1 && k_ < (n_)) ? l_[k_ * 4] : sl * 2048; const unsigned char* rp_ = dn + (size_t)id_ * 1024 + l15 * 16; \
            _Pragma("unroll") for (int j_ = 0; j_ < 4; ++j_) dd[j_] = *(const u32x4*)(rp_ + j_ * 256); } while (0)
#define XD_MATH(dd, slot_, n_, g_) do { int a0_ = 0, a1_ = 0; \
            if (MODE == 2) { _Pragma("unroll") for (int j_ = 0; j_ < 4; ++j_) a0_ ^= (int)(dd[j_][0] ^ dd[j_][1] ^ dd[j_][2] ^ dd[j_][3]); } else { \
            _Pragma("unroll") for (int j_ = 0; j_ < 4; j_ += 2) _Pragma("unroll") for (int q_ = 0; q_ < 4; ++q_) { a0_ = __builtin_amdgcn_sdot4((int)dd[j_][q_], (int)xC[j_][q_], a0_, false); a1_ = __builtin_amdgcn_sdot4((int)dd[j_ + 1][q_], (int)xC[j_ + 1][q_], a1_, false); } } \
            const int d_ = row16_sum_i(a0_ + a1_); \
            LAS int* l_ = lstb + (slot_) * 512; const int k_ = 4 * (g_) + r4; if (k_ < (n_) && l15 == 0) l_[k_ * 4 + 3] = d_; } while (0)
#define XD_FIN_BEGIN(slot_, n_, tok_) do { __builtin_amdgcn_fence(__ATOMIC_RELEASE, "wavefront"); __builtin_amdgcn_wave_barrier(); __builtin_amdgcn_fence(__ATOMIC_ACQUIRE, "wavefront"); \
            const LAS int* l_ = lstb + (slot_) * 512; fin_n = (n_); fin_tok = (tok_); fin_sx = sxC; \
            if (lane < (n_)) { const int id_ = l_[lane * 4]; fin_g = __uint_as_float((unsigned)l_[lane * 4 + 1]); fin_slot = l_[lane * 4 + 2]; fin_dot = l_[lane * 4 + 3]; fin_sd = sdn[id_]; fin_su = sup[id_]; } \
            for (int e_ = 64 + lane; e_ < (n_); e_ += 64) { const int id_ = l_[e_ * 4]; wout[(size_t)(tok_) * 128 + l_[e_ * 4 + 2]] = __uint_as_float((unsigned)l_[e_ * 4 + 1]) * gelu_erf((float)l_[e_ * 4 + 3] * (sxC * sdn[id_])) * sup[id_]; } } while (0)
#define XD_FIN_END() do { if (lane < fin_n) wout[(size_t)fin_tok * 128 + fin_slot] = fin_g * gelu_erf((float)fin_dot * (fin_sx * fin_sd)) * fin_su; fin_n = 0; } while (0)
        XD_LOADI(0); XD_LOADX(xC, sxC, 0);
        XD_LIST(0, nC);
        XD_LOADI(1);
        XD_ISSUE(bufA, 0, nC, 0);
#pragma unroll 1
        for (int k = 0; k < K; ++k) {
            const int sC = k & 1, sN = sC ^ 1; const int tok = t0 + k * tstride;
            XD_FIN_END();
            XD_LIST(sN, nN);
            XD_LOADI(k + 2);
            XD_LOADX(xN, sxN, k + 1);
            const int ngE = nC > 4 ? ((nC + 7) >> 3) << 1 : 2;
#pragma unroll 1
            for (int g = 0; g < ngE; g += 2) {
                XD_ISSUE(bufB, sC, nC, g + 1);
                XD_MATH(bufA, sC, nC, g);
                if (g + 2 < ngE) XD_ISSUE(bufA, sC, nC, g + 2); else XD_ISSUE(bufA, sN, nN, 0);
                XD_MATH(bufB, sC, nC, g + 1);
            }
            XD_FIN_BEGIN(sC, nC, tok);
#pragma unroll
            for (int j = 0; j < 4; ++j) xC[j] = xN[j];
            sxC = sxN; nC = nN;
        }
        XD_FIN_END();
#undef XD_TOK
#undef XD_LOADI
#undef XD_LOADX
#undef XD_LIST
#undef XD_ISSUE
#undef XD_MATH
#undef XD_FIN_BEGIN
#undef XD_FIN_END
    }
}

__device__ __forceinline__ void phase_xup(const Params& p, LAS unsigned char* lds, const int tid0, const SliceInfo si) {
    const int lane = tid0 & 63, w = tid0 >> 6, c8 = lane & 7, q8 = lane >> 3;
    const unsigned char* up = p.ws + WS_UP; const int* ids = (const int*)(p.ws + WS_IDS); const float* wts = (const float*)(p.ws + WS_WB);
    bf16_t* fbuf = (bf16_t*)(p.ws + WS_F); float* ssq = (float*)(p.ws + WS_SSQ);
    LAS int* slots = (LAS int*)lds + w * 512;
    const int t0 = si.rank * 8 + w, tstride = si.nloc * 8;
    const int K = t0 < T ? (T - 1 - t0) / tstride + 1 : 0;
    const bool b32 = (lane & 32) != 0, b16 = (lane & 16) != 0, b8 = (lane & 8) != 0;
    for (int sl = si.sidx; sl < 8; sl += si.nx) {
        if (K == 0) continue;
        int rawA[4], rawB[4]; u32x4 seg0[16], seg1[16]; float swv[2];
#define XU_TOK(k_) (t0 + ((k_) < K ? (k_) : K - 1) * tstride)
#define XU_RAW(rr, k_) do { const size_t o_ = (size_t)XU_TOK(k_) * 128; rr[0] = *(ids + o_ + lane); rr[1] = *(ids + o_ + 64 + lane); \
            rr[2] = (int)__float_as_uint(*(wts + o_ + lane)); rr[3] = (int)__float_as_uint(*(wts + o_ + 64 + lane)); } while (0)
#define XU_LSTAGE(ss, rr, slot_) do { LAS int* s_ = slots + (slot_) * 256; const float wa_ = __uint_as_float((unsigned)rr[2]), wb_ = __uint_as_float((unsigned)rr[3]); \
            const float am_ = wave_max(fmaxf(fabsf(wa_), fabsf(wb_))); const float qs_ = am_ > 0.f ? 127.0f / am_ : 0.f; \
            s_[lane] = rr[0]; s_[64 + lane] = rr[1]; ((LAS signed char*)(s_ + 128))[lane] = (signed char)(int)__builtin_rintf(wa_ * qs_); ((LAS signed char*)(s_ + 128))[64 + lane] = (signed char)(int)__builtin_rintf(wb_ * qs_); \
            swv[slot_] = am_ * (1.0f / 127.0f); __builtin_amdgcn_fence(__ATOMIC_RELEASE, "wavefront"); __builtin_amdgcn_wave_barrier(); __builtin_amdgcn_fence(__ATOMIC_ACQUIRE, "wavefront"); \
            _Pragma("unroll") for (int j_ = 0; j_ < 4; ++j_) { const u32x4 a_ = *(const LAS u32x4*)(s_ + 16 * q8 + 4 * j_); \
                _Pragma("unroll") for (int q_ = 0; q_ < 4; ++q_) ss[4 * j_ + q_] = *(const u32x4*)(up + (size_t)sl * 2097152 + (size_t)a_[q_] * 128 + c8 * 16); } } while (0)
#define XU_MSTAGE(ss, slot_, k_) do { const LAS int* s_ = slots + (slot_) * 256; int ac_[16]; \
            _Pragma("unroll") for (int q_ = 0; q_ < 16; ++q_) ac_[q_] = 0; \
            const u32x4 qw_ = *(const LAS u32x4*)(s_ + 128 + 4 * q8); const float sw_ = swv[slot_]; \
            _Pragma("unroll") for (int j_ = 0; j_ < 4; ++j_) { \
                _Pragma("unroll") for (int q_ = 0; q_ < 4; ++q_) { const int r0_ = (int)ss[4 * j_][q_], r1_ = (int)ss[4 * j_ + 1][q_], r2_ = (int)ss[4 * j_ + 2][q_], r3_ = (int)ss[4 * j_ + 3][q_]; \
                    const int lo01_ = __builtin_amdgcn_perm(r1_, r0_, 0x05010400), hi01_ = __builtin_amdgcn_perm(r1_, r0_, 0x07030602), lo23_ = __builtin_amdgcn_perm(r3_, r2_, 0x05010400), hi23_ = __builtin_amdgcn_perm(r3_, r2_, 0x07030602); \
                    ac_[4 * q_ + 0] = __builtin_amdgcn_sdot4(__builtin_amdgcn_perm(lo23_, lo01_, 0x05040100), (int)qw_[j_], ac_[4 * q_ + 0], false); \
                    ac_[4 * q_ + 1] = __builtin_amdgcn_sdot4(__builtin_amdgcn_perm(lo23_, lo01_, 0x07060302), (int)qw_[j_], ac_[4 * q_ + 1], false); \
                    ac_[4 * q_ + 2] = __builtin_amdgcn_sdot4(__builtin_amdgcn_perm(hi23_, hi01_, 0x05040100), (int)qw_[j_], ac_[4 * q_ + 2], false); \
                    ac_[4 * q_ + 3] = __builtin_amdgcn_sdot4(__builtin_amdgcn_perm(hi23_, hi01_, 0x07060302), (int)qw_[j_], ac_[4 * q_ + 3], false); } } \
            int k8_[8]; \
            _Pragma("unroll") for (int q_ = 0; q_ < 8; ++q_) { const int snd_ = b32 ? ac_[q_] : ac_[8 + q_], kp_ = b32 ? ac_[8 + q_] : ac_[q_]; k8_[q_] = kp_ + __shfl_xor(snd_, 32); } \
            int k4_[4]; \
            _Pragma("unroll") for (int q_ = 0; q_ < 4; ++q_) { const int snd_ = b16 ? k8_[q_] : k8_[4 + q_], kp_ = b16 ? k8_[4 + q_] : k8_[q_]; k4_[q_] = kp_ + __shfl_xor(snd_, 16); } \
            int k2_[2]; \
            _Pragma("unroll") for (int q_ = 0; q_ < 2; ++q_) { const int snd_ = b8 ? k4_[q_] : k4_[2 + q_], kp_ = b8 ? k4_[2 + q_] : k4_[q_]; k2_[q_] = kp_ + __shfl_xor(snd_, 8); } \
            const f32x2 k1_ = (f32x2){(float)k2_[0] * sw_, (float)k2_[1] * sw_}; \
            const float sq_ = wave_sum(k1_.x * k1_.x + k1_.y * k1_.y); \
            if ((k_) < K) { const int tok_ = t0 + (k_) * tstride; const int col_ = sl * 128 + c8 * 16 + (b32 ? 8 : 0) + (b16 ? 4 : 0) + (b8 ? 2 : 0); \
                *(unsigned*)(fbuf + (size_t)tok_ * DM + col_) = cvt_pk_bf16(k1_.x, k1_.y); if (lane == 0) ssq[(size_t)tok_ * 8 + sl] = sq_; } } while (0)
        XU_RAW(rawA, 0);
        XU_LSTAGE(seg0, rawA, 0);
        XU_RAW(rawA, 1); XU_RAW(rawB, 2);
#pragma unroll 1
        for (int k = 0; k < K; k += 2) {
            XU_LSTAGE(seg1, rawA, 1);
            XU_RAW(rawA, k + 3);
            XU_MSTAGE(seg0, 0, k);
            XU_LSTAGE(seg0, rawB, 0);
            XU_RAW(rawB, k + 4);
            XU_MSTAGE(seg1, 1, k + 1);
        }
#undef XU_TOK
#undef XU_RAW
#undef XU_LSTAGE
#undef XU_MSTAGE
    }
}

__device__ __forceinline__ void phase_final(const Params& p, const int tid0) {
    const int lane = tid0 & 63, w = tid0 >> 6;
    const bf16_t* fbuf = (const bf16_t*)(p.ws + WS_F); const float* ssq = (const float*)(p.ws + WS_SSQ); const float* mod = (const float*)(p.ws + WS_MOD);
    const int stride = gridDim.x * 8;
    const bf16_t* x1b = (const bf16_t*)(p.ws + WS_X1B);
    u32x2 fq[4], fqn[4]; u32x2 x1[4], x1n[4]; f32x4 sq[2], sqn[2]; f32x4 pC[4]; int curb = -1;
#define PF_LOAD(fd, xd, sd, r_) do { const int rr_ = (r_) < T ? (r_) : T - 1; _Pragma("unroll") for (int i_ = 0; i_ < 4; ++i_) { fd[i_] = __builtin_nontemporal_load((const u32x2*)(fbuf + (size_t)rr_ * DM + i_ * 256 + lane * 4)); xd[i_] = __builtin_nontemporal_load((const u32x2*)(x1b + (size_t)rr_ * DM + i_ * 256 + lane * 4)); } \
        sd[0] = *(const f32x4*)(ssq + (size_t)rr_ * 8); sd[1] = *(const f32x4*)(ssq + (size_t)rr_ * 8 + 4); } while (0)
    PF_LOAD(fq, x1, sq, blockIdx.x * 8 + w);
    for (int tok = blockIdx.x * 8 + w; tok < T; tok += stride) {
        PF_LOAD(fqn, x1n, sqn, tok + stride);
        const int b = tok / SEQ;
        if (b != curb) {
            curb = b;
#pragma unroll
            for (int i = 0; i < 4; ++i) { const int c = i * 256 + lane * 4; const f32x4 g = *(const f32x4*)(p.g_post_ffn + c), gt2 = *(const f32x4*)(mod + b * 6144 + 5120 + c);
#pragma unroll
                for (int j = 0; j < 4; ++j) pC[i][j] = g[j] * gt2[j]; }
        }
        const float ss = (sq[0][0] + sq[0][1]) + (sq[0][2] + sq[0][3]) + (sq[1][0] + sq[1][1]) + (sq[1][2] + sq[1][3]);
        const float rstd = rsqrtf(ss * (1.0f / DM) + NORM_EPS);
#pragma unroll
        for (int i = 0; i < 4; ++i) { const int c = i * 256 + lane * 4; float* op = p.out + (size_t)tok * DM + c;
            const f32x4 fv = (f32x4){bf_lo(fq[i].x), bf_hi(fq[i].x), bf_lo(fq[i].y), bf_hi(fq[i].y)}, xv = (f32x4){bf_lo(x1[i].x), bf_hi(x1[i].x), bf_lo(x1[i].y), bf_hi(x1[i].y)};
            f32x4 o;
#pragma unroll
            for (int j = 0; j < 4; ++j) o[j] = xv[j] + pC[i][j] * (fv[j] * rstd);
            *(f32x4*)op = o; }
#pragma unroll
        for (int i = 0; i < 4; ++i) { fq[i] = fqn[i]; x1[i] = x1n[i]; }
        sq[0] = sqn[0]; sq[1] = sqn[1];
    }
#undef PF_LOAD
}

#define XB_TMO      128
#define XB_XCNT(j)  (256  + 64 * (j))
#define XB_XSUB(j)  (1280 + 64 * (j))
#define XB_XGEN(j)  (2304 + 64 * (j))
#define XB_TOP      3328
#define XB_TOPGEN   3392
#define XCD_BAR_WORDS 3456
#define XB_SPIN_CAP (1u << 18)

__device__ __forceinline__ unsigned xb_ld(unsigned* p)              { return __hip_atomic_load(p, __ATOMIC_RELAXED, __HIP_MEMORY_SCOPE_AGENT); }
__device__ __forceinline__ unsigned xb_add(unsigned* p, unsigned v) { return __hip_atomic_fetch_add(p, v, __ATOMIC_RELAXED, __HIP_MEMORY_SCOPE_AGENT); }
__device__ __forceinline__ unsigned xb_xcc_id() { return (unsigned)__builtin_amdgcn_s_getreg((3 << 11) | 20) & 0xFu; }
#define XB_SPIN(cond, bar) do { unsigned _sp = 0; while (cond) { __builtin_amdgcn_s_sleep(1); \
    if ((++_sp & 255u) == 0u) { if (xb_ld(&(bar)[XB_TMO])) break; if (_sp > XB_SPIN_CAP) { atomicAdd(&(bar)[XB_TMO], 1u); break; } } } } while (0)

struct XcdBarrier {
    unsigned* bar; unsigned x;
    volatile LAS unsigned* st;
};

__device__ __forceinline__ XcdBarrier xcd_barrier_post(unsigned* bar, volatile LAS unsigned* st) {
    XcdBarrier b; b.bar = bar; b.x = xb_xcc_id(); b.st = st;
    if (threadIdx.x == 0) (void)xb_add(&bar[XB_XCNT(b.x)], 1u);
    return b;
}
__device__ __forceinline__ void xcd_barrier_complete(unsigned* bar, unsigned x, unsigned& nloc, unsigned& nx) {
    const unsigned G = gridDim.x * gridDim.y * gridDim.z;
    unsigned sum, cnt, mine, sp = 0u;
    for (;;) {
        sum = 0u; cnt = 0u; mine = 0u;
#pragma unroll
        for (unsigned j = 0; j < 16; ++j) { const unsigned c = xb_ld(&bar[XB_XCNT(j)]); sum += c; cnt += (c > 0u) ? 1u : 0u; mine = (j == x) ? c : mine; }
        if (sum == G) break;
        __builtin_amdgcn_s_sleep(1);
        if ((++sp & 255u) == 0u) { if (xb_ld(&bar[XB_TMO])) break; if (sp > XB_SPIN_CAP) { atomicAdd(&bar[XB_TMO], 1u); break; } }
    }
    nloc = mine > 0u ? mine : 1u; nx = cnt > 0u ? cnt : 1u;
}

__device__ __forceinline__ void xcd_barrier(const XcdBarrier& b) {
    asm volatile("s_waitcnt vmcnt(0)" ::: "memory");
    __syncthreads();
    if (threadIdx.x == 0) {
        unsigned* bar = b.bar;
        __builtin_amdgcn_s_waitcnt(0);
        unsigned nloc = b.st[0], nx = b.st[1];
        if (nloc == 0u) { xcd_barrier_complete(bar, b.x, nloc, nx); b.st[0] = nloc; b.st[1] = nx; }
        const unsigned old = xb_add(&bar[XB_XSUB(b.x)], 1u);
        const unsigned gen = old / nloc;
        if (old + 1u == (gen + 1u) * nloc) {
            __builtin_amdgcn_fence(__ATOMIC_RELEASE, "agent");
            asm volatile("s_waitcnt vmcnt(0)" ::: "memory");
            const unsigned og = xb_add(&bar[XB_TOP], 1u);
            const unsigned tg = og / nx;
            if (og + 1u == (tg + 1u) * nx) xb_add(&bar[XB_TOPGEN], 1u);
            else XB_SPIN(xb_ld(&bar[XB_TOPGEN]) == tg, bar);
            __builtin_amdgcn_fence(__ATOMIC_ACQUIRE, "agent");
            xb_add(&bar[XB_XGEN(b.x)], 1u);
            asm volatile("s_waitcnt vmcnt(0)" ::: "memory");
        } else {
            XB_SPIN(xb_ld(&bar[XB_XGEN(b.x)]) == gen, bar);
            __builtin_amdgcn_fence(__ATOMIC_ACQUIRE, "agent");
            asm volatile("s_waitcnt vmcnt(0)" ::: "memory");
        }
    }
    __syncthreads();
}


constexpr int NPH = 17;
#ifndef PROBE_MASK
#define PROBE_MASK 0
#endif
__device__ __forceinline__ void run_gemm(LAS unsigned char* lds, const bf16_t* A, const bf16_t* Bt, int N, int K, int kind, unsigned char* ws, unsigned char* dout) {
    pg8::Gemm g{A, Bt, T, N, K}; EpiGen E{kind, ws, dout}; pg8::StaticOrder S; S.init(g.M, g.N, (int)gridDim.x, (int)blockIdx.x); pg8::gemm_phase<EpiGen, pg8::StaticOrder>(lds, g, S, E);
}
#define XB_RANK(j) (XCD_BAR_WORDS + 64 * (j))
constexpr int CTL_WORDS = XCD_BAR_WORDS + 64 * 16;
__device__ __forceinline__ SliceInfo slice_info(const Params& p, const XcdBarrier& xb, volatile LAS unsigned* xst) {
    unsigned* bar = (unsigned*)(p.ws + WS_CTL);
    if (threadIdx.x == 0) { unsigned below = 0u;
        for (unsigned j = 0; j < 16; ++j) { const unsigned c = xb_ld(&bar[XB_XCNT(j)]); if (c > 0u && j < xb.x) ++below; }
        xst[3] = below; }
    __syncthreads();
    SliceInfo si; si.nloc = (int)xst[0]; si.nx = (int)xst[1]; si.rank = (int)xst[2]; si.sidx = (int)xst[3];
    if (si.nloc < 1) si.nloc = 1; if (si.nx < 1) si.nx = 1; if (si.rank >= si.nloc) si.rank = si.rank % si.nloc; if (si.sidx >= si.nx) si.sidx = si.sidx % si.nx;
    return si;
}
__global__ void __launch_bounds__(512, 2) fwd_kernel(Params p) {
    extern __shared__ __attribute__((aligned(16))) unsigned char shm[];
    LAS unsigned char* lds = (LAS unsigned char*)shm;
    volatile LAS unsigned* xst = (volatile LAS unsigned*)(lds + LDS_MAIN);
    if (threadIdx.x == 0) { xst[0] = 0u; xst[1] = 0u; xst[2] = 0u; xst[3] = 0u; }
    __syncthreads();
    const XcdBarrier xb = xcd_barrier_post((unsigned*)(p.ws + WS_CTL), xst);
    if (threadIdx.x == 0) xst[2] = xb_add((unsigned*)(p.ws + WS_CTL) + XB_RANK(xb.x), 1u);
    const int lo = (int)p.ph_lo, hi = (int)p.ph_hi;
    unsigned char* const dout = (unsigned char*)p.out;
#if PROBE_MASK
#define PHASE(k, body) if (lo <= (k) && (k) < hi) { { const int tid0 = threadIdx.x; body; } if ((PROBE_MASK >> (k)) & 1) { xcd_barrier(xb); int tid0 = threadIdx.x; asm volatile("" : "+v"(tid0)); body; } if ((k) + 1 < hi) xcd_barrier(xb); }
#else
#define PHASE(k, body) if (lo <= (k) && (k) < hi) { const int tid0 = threadIdx.x; body; if ((k) + 1 < hi) xcd_barrier(xb); }
#endif
    PHASE(0, phase_prep(p, lds, tid0))
    PHASE(1, phase_h(p, tid0))
    PHASE(2, run_gemm(lds, (const bf16_t*)(dout + DO_H), (const bf16_t*)(p.ws + WS_WIN_T), NA, 1024, EK_A, p.ws, dout))
    PHASE(3, phase_attn(p, lds, tid0))
    PHASE(4, phase_combine(p, tid0); __syncthreads(); run_gemm(lds, (const bf16_t*)(dout + DO_H), (const bf16_t*)(p.ws + WS_WIN_T) + (size_t)NA * 1024, NBC, 1024, EK_B, p.ws, dout))
    PHASE(5, phase_kv(p, lds, tid0))
    PHASE(6, phase_scan(p, tid0))
    PHASE(7, phase_ret(p, lds, tid0))
    PHASE(8, run_gemm(lds, (const bf16_t*)(dout + DO_YATT), (const bf16_t*)(p.ws + WS_WA_T), 1024, 512, EK_C, p.ws, dout); __syncthreads();
             run_gemm(lds, (const bf16_t*)(p.ws + WS_RO), (const bf16_t*)(p.ws + WS_WR_T), 1024, 1024, EK_D, p.ws, dout))
    PHASE(10, run_gemm(lds, (const bf16_t*)(p.ws + WS_Y), (const bf16_t*)(p.ws + WS_WMX_T), 1024, 1024, EK_E, p.ws, dout))
    PHASE(11, phase_rows(p, tid0))
    PHASE(12, run_gemm(lds, (const bf16_t*)(p.ws + WS_H2), (const bf16_t*)(p.ws + WS_WPQ_T), 2048, 1024, EK_F, p.ws, dout))
    PHASE(13, phase_route(p, lds, tid0))
#ifdef XDN_PROBE
    PHASE(14, phase_xdown<XDN_PROBE>(p, lds, tid0, slice_info(p, xb, xst)); xcd_barrier(xb); phase_xdown<0>(p, lds, tid0, slice_info(p, xb, xst)))
#else
    PHASE(14, phase_xdown<0>(p, lds, tid0, slice_info(p, xb, xst)))
#endif
    PHASE(15, phase_xup(p, lds, tid0, slice_info(p, xb, xst)))
    PHASE(16, phase_final(p, tid0))
#undef PHASE
}

extern "C" void kernel_launch(void* const* d_in, const int* in_sizes, int n_in, void* d_out, int out_size, void* d_ws, size_t ws_size, hipStream_t stream) {
    static int grid_blocks = 0;
    if (grid_blocks == 0) {
        if (n_in != 18 || ws_size < WS_END) { fprintf(stderr, "kernel_launch: unexpected n_in %d / ws_size %zu\n", n_in, ws_size); grid_blocks = -1; return; }
        int dev = 0, cus = 0, per_cu = 0;
        hipGetDevice(&dev); hipDeviceGetAttribute(&cus, hipDeviceAttributeMultiprocessorCount, dev);
        if (hipFuncSetAttribute((const void*)fwd_kernel, hipFuncAttributeMaxDynamicSharedMemorySize, LDS_BYTES) != hipSuccess) { fprintf(stderr, "kernel_launch: hipFuncSetAttribute failed\n"); grid_blocks = -1; return; }
        hipOccupancyMaxActiveBlocksPerMultiprocessor(&per_cu, (const void*)fwd_kernel, 512, LDS_BYTES);
        if (per_cu < 1) { fprintf(stderr, "kernel_launch: occupancy query says %d blocks per CU\n", per_cu); per_cu = 1; }
        grid_blocks = cus;
        (void)hipGetLastError();
    }
    if (grid_blocks < 0) return;
    if (hipMemsetAsync((unsigned char*)d_ws + WS_CTL, 0, CTL_WORDS * sizeof(unsigned), stream) != hipSuccess) { fprintf(stderr, "kernel_launch: hipMemsetAsync failed\n"); return; }
    Params p{};
    p.x = (const float*)d_in[0]; p.c = (const float*)d_in[1]; p.pos = (const int*)d_in[2]; p.w_ada = (const float*)d_in[3]; p.b_ada = (const float*)d_in[4];
    p.g_pre_mix = (const float*)d_in[5]; p.g_post_mix = (const float*)d_in[6]; p.w_in = (const float*)d_in[7]; p.w_att = (const float*)d_in[8]; p.w_ret = (const float*)d_in[9];
    p.w_mix = (const float*)d_in[10]; p.g_pre_ffn = (const float*)d_in[11]; p.g_post_ffn = (const float*)d_in[12]; p.w_pq = (const float*)d_in[13]; p.keys1 = (const float*)d_in[14];
    p.keys2 = (const float*)d_in[15]; p.down = (const float*)d_in[16]; p.up = (const float*)d_in[17]; p.out = (float*)d_out; p.ws = (unsigned char*)d_ws;
#if defined(MULTI_LAUNCH)
    for (int ph = 0; ph < NPH; ++ph) { p.ph_lo = ph; p.ph_hi = ph + 1; hipLaunchKernelGGL(fwd_kernel, dim3(grid_blocks), dim3(512), LDS_BYTES, stream, p); }
#else
    p.ph_lo = 0; p.ph_hi = NPH; p.rep_mask = PROBE_MASK;
    void* args[] = {&p};
    hipError_t e = hipLaunchCooperativeKernel((const void*)fwd_kernel, dim3(grid_blocks), dim3(512), args, LDS_BYTES, stream);
    if (e != hipSuccess) fprintf(stderr, "cooperative launch failed: %s (grid %d)\n", hipGetErrorString(e), grid_blocks);
#endif
}
```

```cpp
#include <hip/hip_runtime.h>
#include <hip/hip_cooperative_groups.h>
#include <cstdio>
namespace cg = cooperative_groups;

#define LAS __attribute__((address_space(3)))
typedef unsigned short bf16_t;
typedef short bf16x8 __attribute__((ext_vector_type(8)));
typedef short s16x4 __attribute__((ext_vector_type(4)));
typedef float f32x4 __attribute__((ext_vector_type(4)));
typedef float f32x2 __attribute__((ext_vector_type(2)));
typedef unsigned u32x4 __attribute__((ext_vector_type(4)));
typedef unsigned u32x2 __attribute__((ext_vector_type(2)));

constexpr int NB = 4, SEQ = 8192, T = NB * SEQ, DM = 1024;
constexpr int ATT_W = 1536, RET_QK_W = 512, RET_V_W = 1024, IN_W = 9728;
constexpr int NA = 4608;
constexpr int NBC = 5120;
constexpr float NORM_EPS = 1e-6f;
constexpr size_t MiB = 1ull << 20;

constexpr size_t WS_CTL   = 0;
constexpr size_t WS_MOD   = 65536;
constexpr size_t WS_WIN_T = 1 * MiB;
constexpr size_t WS_WA_T  = 20 * MiB;
constexpr size_t WS_WR_T  = 21 * MiB;
constexpr size_t WS_WMX_T = 23 * MiB;
constexpr size_t WS_WPQ_T = 25 * MiB;
constexpr size_t WS_KEYS  = 29 * MiB;
constexpr size_t WS_ROPE  = 30 * MiB;
constexpr size_t WS_R1    = 48 * MiB;
constexpr size_t WS_AQ = WS_R1, WS_AK = WS_R1 + 96 * MiB, WS_AV = WS_R1 + 192 * MiB;
constexpr size_t WS_RQ = WS_R1, WS_RK = WS_R1 + 32 * MiB, WS_RV = WS_R1 + 64 * MiB, WS_RG = WS_R1 + 128 * MiB, WS_GA = WS_R1 + 192 * MiB;
constexpr size_t WS_KV = 304 * MiB;
constexpr size_t WS_RO = 304 * MiB;
constexpr size_t WS_OG = 336 * MiB;
constexpr size_t WS_LSE = 432 * MiB;
constexpr size_t WS_GR = 434 * MiB;
constexpr size_t WS_Y1 = WS_R1;
constexpr size_t WS_Y  = WS_R1 + 64 * MiB;
constexpr size_t WS_YM = WS_R1 + 128 * MiB;
constexpr size_t WS_H2 = WS_R1;
constexpr size_t WS_DN = 304 * MiB;
constexpr size_t WS_UP = 368 * MiB;
constexpr size_t WS_QP = WS_R1 + 64 * MiB;
constexpr size_t WS_X1B = 240 * MiB;
constexpr size_t WS_IDS = 320 * MiB;
constexpr size_t WS_GT  = 336 * MiB;
constexpr size_t WS_F   = WS_R1 + 64 * MiB;
constexpr size_t WS_SSQ = 466 * MiB;
constexpr size_t WS_WB  = 352 * MiB;
constexpr size_t WS_H2Q = 434 * MiB;
constexpr size_t WS_SX  = 498 * MiB;
constexpr size_t WS_SDN = 499 * MiB;
constexpr size_t WS_SUP = 499 * MiB + 65536;
constexpr size_t WS_END = 500 * MiB;
constexpr size_t DO_H = 0, DO_YATT = 64 * MiB, DO_RPREV = 0;

constexpr int LDS_MAIN = 143360, LDS_BYTES = LDS_MAIN + 16;

struct Params {
    const float* x; const float* c; const int* pos; const float* w_ada; const float* b_ada; const float* g_pre_mix; const float* g_post_mix; const float* w_in;
    const float* w_att; const float* w_ret; const float* w_mix; const float* g_pre_ffn; const float* g_post_ffn; const float* w_pq; const float* keys1; const float* keys2;
    const float* down; const float* up; float* out; unsigned char* ws; long long ph_lo, ph_hi, rep_mask;
};

__device__ __forceinline__ unsigned cvt_pk_bf16(float lo, float hi) { unsigned r; asm("v_cvt_pk_bf16_f32 %0, %1, %2" : "=v"(r) : "v"(lo), "v"(hi)); return r; }
__device__ __forceinline__ unsigned cvt_pk_bf16_t(float lo, float hi) { unsigned r; asm("s_nop 0\n\tv_cvt_pk_bf16_f32 %0, %1, %2" : "=v"(r) : "v"(lo), "v"(hi)); return r; }
__device__ __forceinline__ float bf_lo(unsigned u) { return __uint_as_float(u << 16); }
__device__ __forceinline__ float bf_hi(unsigned u) { return __uint_as_float(u & 0xffff0000u); }
__device__ __forceinline__ int dpp_i(int v, const int ctrl) { return ctrl == 0xB1 ? __builtin_amdgcn_update_dpp(0, v, 0xB1, 0xF, 0xF, false) : ctrl == 0x4E ? __builtin_amdgcn_update_dpp(0, v, 0x4E, 0xF, 0xF, false) : ctrl == 0x141 ? __builtin_amdgcn_update_dpp(0, v, 0x141, 0xF, 0xF, false) : __builtin_amdgcn_update_dpp(0, v, 0x140, 0xF, 0xF, false); }
__device__ __forceinline__ float dpp_f(float v, const int ctrl) { return __uint_as_float((unsigned)dpp_i((int)__float_as_uint(v), ctrl)); }
__device__ __forceinline__ int row16_sum_i(int d) { d += dpp_i(d, 0xB1); d += dpp_i(d, 0x4E); d += dpp_i(d, 0x141); d += dpp_i(d, 0x140); return d; }
__device__ __forceinline__ float row16_sum_f(float d) { d += dpp_f(d, 0xB1); d += dpp_f(d, 0x4E); d += dpp_f(d, 0x141); d += dpp_f(d, 0x140); return d; }
__device__ __forceinline__ float row16_max_f(float d) { d = fmaxf(d, dpp_f(d, 0xB1)); d = fmaxf(d, dpp_f(d, 0x4E)); d = fmaxf(d, dpp_f(d, 0x141)); d = fmaxf(d, dpp_f(d, 0x140)); return d; }
__device__ __forceinline__ float wave_sum(float v) { v = row16_sum_f(v); v += __shfl_xor(v, 16); v += __shfl_xor(v, 32); return v; }
__device__ __forceinline__ float fast_exp2(float x) { return __builtin_amdgcn_exp2f(x); }
__device__ __forceinline__ float sigmoidf_(float x) { return __builtin_amdgcn_rcpf(1.0f + __expf(-x)); }
__device__ __forceinline__ int perm_logical(int nphys, bool rope) {
    const int p = nphys & 255, base = nphys & ~255, lo = 8 * ((p >> 2) & 3) + 4 * ((p >> 4) & 1) + (p & 3);
    return rope ? base + 128 * ((p >> 6) & 1) + 64 * (p >> 7) + 32 * ((p >> 5) & 1) + lo : base + 64 * ((p >> 5) & 3) + 32 * (p >> 7) + lo;
}
__device__ __forceinline__ s16x4 lds_tr(const LAS unsigned char* a) { return __builtin_amdgcn_ds_read_tr16_b64_v4i16((LAS s16x4*)a); }
__device__ __forceinline__ bf16x8 cat8(s16x4 lo, s16x4 hi) { return (bf16x8){lo[0], lo[1], lo[2], lo[3], hi[0], hi[1], hi[2], hi[3]}; }
namespace pg8 {
constexpr int BM = 256, BK = 64, HALF = 128, HTB = HALF * BK * 2  , STAGE_BYTES = 8 * HTB, NXCD = 8, WGM = 8;

__host__ __device__ __forceinline__ int lds_byte(int r, int c) { const int st = (r >> 4) * 2 + (c >> 5), rr = r & 15, cc = c & 31, ob = rr * 64 + cc * 2; return st * 1024 + (ob ^ (((ob >> 9) & 1) << 5)); }
__host__ __device__ __forceinline__ void stage_rc(int b, int& R, int& C) { const int st = b / 1024, sb = b % 1024, swz = sb ^ (((sb >> 9) & 1) << 5); R = (st >> 1) * 16 + swz / 64; C = (st & 1) * 32 + (swz % 64) / 2; }
__host__ __device__ __forceinline__ int perm32(int rho) { const int n = rho >> 4, i = rho & 15; return 8 * (i >> 2) + 4 * n + (i & 3); }

struct Unit { int pm, pn; };
struct Gemm { const bf16_t* A; const bf16_t* Bt; int M, N, K; };

struct StaticOrder {
    int nM, nN, nwg, G, c;
    __host__ __device__ void init(int M, int N, int G_, int c_) { nM = M / BM; nN = N / BM; nwg = nM * nN; G = G_; c = c_; }
    __device__ bool next(int i, Unit& u) const {
        const int L = i * G + c; if (L >= nwg) return false;
        int wgid = L; { const int q = nwg / NXCD, r = nwg % NXCD, xcd = wgid % NXCD, off = wgid / NXCD; wgid = (xcd < r ? xcd * (q + 1) : r * (q + 1) + (xcd - r) * q) + off; }
        const int nig = WGM * nN, gid = wgid / nig, fm = gid * WGM, gsz = (nM - fm) < WGM ? (nM - fm) : WGM;
        u.pm = __builtin_amdgcn_readfirstlane(fm + ((wgid % nig) % gsz)); u.pn = __builtin_amdgcn_readfirstlane((wgid % nig) / gsz); return true;
    }
    __device__ __forceinline__ void a_ready(const Unit&) const {}
    __device__ __forceinline__ void done(const Unit&) const {}
};

template <class Epi, class Sched>
__device__ __forceinline__ void gemm_phase(LAS unsigned char* lds, const Gemm g, const Sched& S, const Epi& E) {
    const int tid = threadIdx.x, wid = __builtin_amdgcn_readfirstlane(tid >> 6), lane = tid & 63, wr = wid >> 2, wc = wid & 3, fr = lane & 15, fq = lane >> 4;
    const int K = g.K, nt = K / BK;
    unsigned voffA[2], voffB[2];
#pragma unroll
    for (int i = 0; i < 2; ++i) { int R, C; stage_rc(tid * 16 + i * 8192, R, C); const int Rb = Epi::PERM ? ((R & ~31) + perm32(R & 31)) : R;
        voffA[i] = (unsigned)(R * K + C) * 2u; voffB[i] = (unsigned)(Rb * K + C) * 2u; }
    const size_t kstep = (size_t)(BK * 2);
    const size_t hstep = (size_t)HALF * K * 2;
    const size_t tstep = 2 * hstep;
    const unsigned ldsw = (unsigned)wid * 1024u;
    const int aoff = lds_byte(wr * 64 + fr, fq * 8), boff = lds_byte(wc * 32 + fr, fq * 8);
#define PG8_SA(b, h) (((b) * 2 + (h)) * HTB)
#define PG8_SB(b, h) ((4 + (b) * 2 + (h)) * HTB)
#define PG8_STAGE(bufoff, gbase, voff) do { _Pragma("unroll") for (int _i = 0; _i < 2; ++_i) \
        __builtin_amdgcn_global_load_lds((const unsigned*)((const char*)(gbase) + (voff)[_i]), (LAS unsigned*)(lds + (bufoff) + ldsw + _i * 8192), 16, 0, 0); } while (0)
#define PG8_LDA(dst, b, h) do { _Pragma("unroll") for (int m = 0; m < 4; ++m) _Pragma("unroll") for (int k = 0; k < 2; ++k) dst[m][k] = *(const LAS bf16x8*)(lds + PG8_SA(b, h) + aoff + m * 2048 + k * 1024); } while (0)
#define PG8_LDB(dst, b, h) do { _Pragma("unroll") for (int n = 0; n < 2; ++n) _Pragma("unroll") for (int k = 0; k < 2; ++k) dst[n][k] = *(const LAS bf16x8*)(lds + PG8_SB(b, h) + boff + n * 2048 + k * 1024); } while (0)
#define PG8_MMA(ai, bj, At, Bt) do { __builtin_amdgcn_s_setprio(1); _Pragma("unroll") for (int m = 0; m < 4; ++m) _Pragma("unroll") for (int n = 0; n < 2; ++n) _Pragma("unroll") for (int k = 0; k < 2; ++k) \
        acc[ai][bj][m][n] = __builtin_amdgcn_mfma_f32_16x16x32_bf16(Bt[n][k], At[m][k], acc[ai][bj][m][n], 0, 0, 0); __builtin_amdgcn_s_setprio(0); } while (0)
#define PG8_WAIT_V(n) asm volatile("s_waitcnt vmcnt(" #n ")" ::: "memory")
#define PG8_WAIT_L(n) asm volatile("s_waitcnt lgkmcnt(" #n ")" ::: "memory")
#define PG8_BAR __builtin_amdgcn_s_barrier()
#define PG8_SCHED __builtin_amdgcn_sched_barrier(0)
    Unit cur, nxt; int ui = 0;
    if (!S.next(0, cur)) return;
    f32x4 acc[2][2][4][2];
#pragma unroll
    for (int a = 0; a < 2; ++a)
#pragma unroll
        for (int b = 0; b < 2; ++b)
#pragma unroll
            for (int m = 0; m < 4; ++m)
#pragma unroll
                for (int n = 0; n < 2; ++n) acc[a][b][m][n] = (f32x4){0.f, 0.f, 0.f, 0.f};
    bf16x8 At[4][2], B0[2][2], B1[2][2];
    const char* cA = (const char*)g.A + (size_t)cur.pm * tstep; const char* cB = (const char*)g.Bt + (size_t)cur.pn * tstep;
    S.a_ready(cur);
    PG8_STAGE(PG8_SB(0, 0), cB, voffB); PG8_STAGE(PG8_SA(0, 0), cA, voffA); PG8_STAGE(PG8_SB(0, 1), cB + hstep, voffB); PG8_STAGE(PG8_SA(0, 1), cA + hstep, voffA);
    if (wr == 1) PG8_BAR;
    PG8_WAIT_V(4); PG8_BAR;
    PG8_STAGE(PG8_SB(1, 0), cB + kstep, voffB); PG8_STAGE(PG8_SA(1, 0), cA + kstep, voffA); PG8_STAGE(PG8_SB(1, 1), cB + hstep + kstep, voffB);
    PG8_WAIT_V(6); PG8_BAR;
    for (;;) {
        const bool has_next = S.next(ui + 1, nxt);
        const char* nA = has_next ? (const char*)g.A + (size_t)nxt.pm * tstep : cA; const char* nB = has_next ? (const char*)g.Bt + (size_t)nxt.pn * tstep : cB;
        for (int t = 0; t < nt; t += 2) {
            const bool last = (t == nt - 2);
            const char* a1 = cA + (size_t)(t + 1) * kstep;
            const char* a2 = last ? nA : cA + (size_t)(t + 2) * kstep; const char* b2 = last ? nB : cB + (size_t)(t + 2) * kstep;
            const char* a3 = a2 + kstep; const char* b3 = b2 + kstep;
            if (last && has_next) S.a_ready(nxt);
            PG8_LDB(B0, 0, 0); PG8_SCHED; PG8_LDA(At, 0, 0); PG8_STAGE(PG8_SA(1, 1), a1 + hstep, voffA);
            PG8_WAIT_L(8); PG8_BAR; PG8_WAIT_L(0); PG8_MMA(0, 0, At, B0); PG8_BAR; PG8_SCHED;
            PG8_LDB(B1, 0, 1); PG8_STAGE(PG8_SB(0, 0), b2, voffB);
            PG8_BAR; PG8_WAIT_L(0); PG8_MMA(0, 1, At, B1); PG8_BAR;
            PG8_LDA(At, 0, 1); PG8_STAGE(PG8_SA(0, 0), a2, voffA);
            PG8_BAR; PG8_WAIT_L(0); PG8_MMA(1, 0, At, B0); PG8_BAR; PG8_SCHED;
            PG8_STAGE(PG8_SB(0, 1), b2 + hstep, voffB);
            PG8_WAIT_V(6); PG8_BAR; PG8_MMA(1, 1, At, B1); PG8_BAR;
            PG8_LDB(B0, 1, 0); PG8_SCHED; PG8_LDA(At, 1, 0); PG8_STAGE(PG8_SA(0, 1), a2 + hstep, voffA);
            PG8_WAIT_L(8); PG8_BAR; PG8_WAIT_L(0); PG8_MMA(0, 0, At, B0); PG8_BAR; PG8_SCHED;
            PG8_LDB(B1, 1, 1); PG8_STAGE(PG8_SB(1, 0), b3, voffB);
            PG8_BAR; PG8_WAIT_L(0); PG8_MMA(0, 1, At, B1); PG8_BAR;
            PG8_LDA(At, 1, 1); PG8_STAGE(PG8_SA(1, 0), a3, voffA);
            PG8_BAR; PG8_WAIT_L(0); PG8_MMA(1, 0, At, B0); PG8_BAR; PG8_SCHED;
            PG8_STAGE(PG8_SB(1, 1), b3 + hstep, voffB);
            PG8_WAIT_V(6); PG8_BAR; PG8_MMA(1, 1, At, B1); PG8_BAR;
        }
        if constexpr (!Epi::AFTER_DRAIN) { E(acc, cur, wr, wc, fr, fq); S.done(cur); }
        if (!has_next) break;
#pragma unroll
        for (int a = 0; a < 2; ++a)
#pragma unroll
            for (int b = 0; b < 2; ++b)
#pragma unroll
                for (int m = 0; m < 4; ++m)
#pragma unroll
                    for (int n = 0; n < 2; ++n) acc[a][b][m][n] = (f32x4){0.f, 0.f, 0.f, 0.f};
        cur = nxt; cA = nA; cB = nB; ++ui;
    }
    PG8_WAIT_V(0);
    if (wr == 0) PG8_BAR;
    PG8_BAR;
    if constexpr (Epi::AFTER_DRAIN) { E.fused(acc, cur, wr, wc, fr, fq, lds, wid, lane); S.done(cur); }
#undef PG8_SA
#undef PG8_SB
#undef PG8_STAGE
#undef PG8_LDA
#undef PG8_LDB
#undef PG8_MMA
#undef PG8_WAIT_V
#undef PG8_WAIT_L
#undef PG8_BAR
#undef PG8_SCHED
}
}


__device__ __forceinline__ size_t att_row_off(int tok, int h12) { const int b = tok >> 13, s = tok & (SEQ - 1), dsh = (h12 >> 2) * 2; const int ps = ((s & ((1 << dsh) - 1)) << (13 - dsh)) + (s >> dsh); return ((size_t)(b * 12 + h12) * SEQ + ps) * 128; }
enum { EK_A = 0, EK_B = 1, EK_C = 2, EK_D = 3, EK_E = 4, EK_F = 5 };
struct EpiGen {
    static constexpr bool PERM = false, AFTER_DRAIN = false;
    int kind; unsigned char* ws; unsigned char* dout;
    __device__ __forceinline__ void operator()(const f32x4 (&acc)[2][2][4][2], const pg8::Unit& u, int wr, int wc, int fr, int fq) const {
        int mode = 0, ld = 1024, colbase = 0; size_t dsto = 0; float sc = 1.0f;
        const int pn = u.pn;
        bool attl = false;
        if (kind == EK_A) { const int tq = pn / 6; colbase = (pn - tq * 6) * 256; ld = ATT_W; dsto = WS_AQ + (size_t)tq * 96 * MiB; mode = tq < 2 ? 1 : 0; sc = tq == 0 ? 0.08838834764831845f * 1.4426950408889634f : 1.0f; attl = true; }
        else if (kind == EK_B) {
            if (pn < 2)       { mode = 1; ld = RET_QK_W; colbase = pn * 256; dsto = WS_RQ; }
            else if (pn < 4)  { mode = 1; ld = RET_QK_W; colbase = (pn - 2) * 256; dsto = WS_RK; sc = 0.08838834764831845f; }
            else if (pn < 8)  { mode = 0; colbase = (pn - 4) * 256; dsto = WS_RV; }
            else if (pn < 12) { mode = 2; colbase = (pn - 8) * 256; dsto = WS_RG; }
            else if (pn < 16) { mode = 3; colbase = (pn - 12) * 256; dsto = WS_GA; }
            else              { mode = 3; colbase = (pn - 16) * 256; dsto = WS_GR; }
        }
        else if (kind == EK_C) { mode = 4; colbase = pn * 256; dsto = WS_Y1; }
        else if (kind == EK_D) { mode = 5; colbase = pn * 256; dsto = WS_Y; }
        else if (kind == EK_E) { mode = 0; colbase = pn * 256; dsto = WS_YM; }
        else                   { mode = 0; ld = 2048; colbase = pn * 256; dsto = WS_QP; }
        const int row0 = u.pm * 256 + wr * 64 + fr;
        if (mode == 1) {
            bf16_t* dst = (bf16_t*)(ws + dsto);
            const unsigned* rope = (const unsigned*)(ws + WS_ROPE);
            const int d0 = 32 * (wc & 1) + 8 * fq, cb = colbase + 128 * (wc >> 1) + d0;
            u32x4 cq[2][4][2];
#pragma unroll
            for (int ai = 0; ai < 2; ++ai)
#pragma unroll
                for (int m = 0; m < 4; ++m) { const unsigned* rp = rope + (size_t)(row0 + ai * 128 + m * 16) * 64 + d0; cq[ai][m][0] = *(const u32x4*)rp; cq[ai][m][1] = *(const u32x4*)(rp + 4); }
#pragma unroll
            for (int ai = 0; ai < 2; ++ai) {
#pragma unroll
                for (int m = 0; m < 4; ++m) {
                    const int row = row0 + ai * 128 + m * 16;
                    u32x4 w1, w2;
#pragma unroll
                    for (int n = 0; n < 2; ++n) {
                        const u32x4 q4 = cq[ai][m][n];
                        const f32x4 x1 = acc[ai][0][m][n], x2 = acc[ai][1][m][n];
                        const float cc[4] = {bf_lo(q4.x), bf_lo(q4.y), bf_lo(q4.z), bf_lo(q4.w)}, ss[4] = {bf_hi(q4.x), bf_hi(q4.y), bf_hi(q4.z), bf_hi(q4.w)};
                        float o1[4], o2[4];
#pragma unroll
                        for (int i = 0; i < 4; ++i) { o1[i] = x1[i] * cc[i] - x2[i] * ss[i]; o2[i] = x1[i] * ss[i] + x2[i] * cc[i]; }
                        w1[2 * n] = cvt_pk_bf16(o1[0], o1[1]); w1[2 * n + 1] = cvt_pk_bf16(o1[2], o1[3]); w2[2 * n] = cvt_pk_bf16(o2[0], o2[1]); w2[2 * n + 1] = cvt_pk_bf16(o2[2], o2[3]);
                    }
                    bf16_t* op = attl ? dst + att_row_off(row, (colbase >> 7) + (wc >> 1)) + d0 : dst + (size_t)row * ld + cb;
                    *(u32x4*)op = w1; *(u32x4*)(op + 64) = w2;
                }
            }
        } else {
            bf16_t* dst = (bf16_t*)(ws + dsto);
            const bf16_t* gate = (const bf16_t*)(ws + (mode == 4 ? WS_GA : WS_GR));
            const bf16_t* y1 = (const bf16_t*)(ws + WS_Y1);
            const int cw = colbase + wc * 64 + 8 * fq;
            u32x4 gq2[4][2];
            if (kind == EK_C) {
#pragma unroll
                for (int m = 0; m < 4; ++m)
#pragma unroll
                    for (int bj = 0; bj < 2; ++bj) { const size_t o = (size_t)(row0 + 128 + m * 16) * ld + cw + bj * 32; gq2[m][bj] = *(const u32x4*)(gate + o); }
            }
#pragma unroll
            for (int ai = 0; ai < 2; ++ai) {
                u32x4 gq[4][2], yq[4][2];
                if (mode >= 4) {
#pragma unroll
                    for (int m = 0; m < 4; ++m)
#pragma unroll
                        for (int bj = 0; bj < 2; ++bj) { const size_t o = (size_t)(row0 + ai * 128 + m * 16) * ld + cw + bj * 32;
                            if (kind == EK_C && ai == 1) gq[m][bj] = gq2[m][bj]; else gq[m][bj] = *(const u32x4*)(gate + o);
                            if (mode == 5) yq[m][bj] = *(const u32x4*)(y1 + o); }
                }
#pragma unroll
                for (int m = 0; m < 4; ++m) {
                    u32x4 wq[2];
#pragma unroll
                    for (int bj = 0; bj < 2; ++bj) {
                        f32x4 v0 = acc[ai][bj][m][0], v1 = acc[ai][bj][m][1];
                        if (mode == 2) {
#pragma unroll
                            for (int i = 0; i < 4; ++i) { v0[i] = v0[i] * sigmoidf_(v0[i]); v1[i] = v1[i] * sigmoidf_(v1[i]); }
                        } else if (mode == 3) {
#pragma unroll
                            for (int i = 0; i < 4; ++i) { v0[i] = sigmoidf_(v0[i]); v1[i] = sigmoidf_(v1[i]); }
                        } else if (mode >= 4) {
                            const u32x4 g = gq[m][bj];
                            v0[0] *= bf_lo(g.x); v0[1] *= bf_hi(g.x); v0[2] *= bf_lo(g.y); v0[3] *= bf_hi(g.y); v1[0] *= bf_lo(g.z); v1[1] *= bf_hi(g.z); v1[2] *= bf_lo(g.w); v1[3] *= bf_hi(g.w);
                            if (mode == 5) { const u32x4 y = yq[m][bj];
                                v0[0] += bf_lo(y.x); v0[1] += bf_hi(y.x); v0[2] += bf_lo(y.y); v0[3] += bf_hi(y.y); v1[0] += bf_lo(y.z); v1[1] += bf_hi(y.z); v1[2] += bf_lo(y.w); v1[3] += bf_hi(y.w); }
                        }
                        if (mode == 3) { wq[bj].x = cvt_pk_bf16_t(v0[0], v0[1]); wq[bj].y = cvt_pk_bf16_t(v0[2], v0[3]); wq[bj].z = cvt_pk_bf16_t(v1[0], v1[1]); wq[bj].w = cvt_pk_bf16_t(v1[2], v1[3]); }
                        else { wq[bj].x = cvt_pk_bf16(v0[0], v0[1]); wq[bj].y = cvt_pk_bf16(v0[2], v0[3]); wq[bj].z = cvt_pk_bf16(v1[0], v1[1]); wq[bj].w = cvt_pk_bf16(v1[2], v1[3]); }
                    }
                    const int rA = row0 + ai * 128 + m * 16;
                    if (attl) { const int hd = (colbase >> 7) + (wc >> 1), wo = (wc & 1) * 64 + 8 * fq;
                        bf16_t* op = dst + att_row_off(rA, hd) + wo; *(u32x4*)op = wq[0]; *(u32x4*)(op + 32) = wq[1]; }
                    else { bf16_t* op = dst + (size_t)rA * ld + cw; *(u32x4*)op = wq[0]; *(u32x4*)(op + 32) = wq[1]; }
                }
            }
        }
    }
};

__device__ __forceinline__ void transpose_tile(const float* __restrict__ W, int K, int N, bf16_t* __restrict__ Wt, int k0, int n0, bool ropeperm, LAS float* tile, const int tid0, const float scale = 1.0f) {
    const int tid = tid0;
#pragma unroll
    for (int i = 0; i < 8; ++i) { const int idx = tid + 512 * i, r = idx >> 6, c = idx & 63; const int nphys = n0 + c, nlog = perm_logical(nphys, ropeperm);
        tile[r * 65 + c] = W[(size_t)(k0 + r) * N + nlog] * scale; }
    __syncthreads();
#pragma unroll
    for (int i = 0; i < 4; ++i) { const int idx = tid + 512 * i, nn = idx >> 5, kk = (idx & 31) * 2;
        *(unsigned*)(Wt + (size_t)(n0 + nn) * K + k0 + kk) = cvt_pk_bf16(tile[kk * 65 + nn], tile[(kk + 1) * 65 + nn]); }
    __syncthreads();
}

template <bool IS_IN>
__device__ __forceinline__ void tt_run(const float* __restrict__ W, bf16_t* __restrict__ Wt, const int K, const int N, const int ktl, const int ntiles, LAS float* tile, const int tid) {
    float fa[8], fb[8];
#define TT_LOAD(f_, tt_) do { const int t_ = (tt_) < ntiles ? (tt_) : ntiles - 1; const int k0_ = (t_ & ((1 << ktl) - 1)) * 64, n0_ = (t_ >> ktl) * 64; \
        const bool rp_ = IS_IN && ((n0_ < 3072) || (n0_ >= 4608 && n0_ < 5632)); const float sc_ = !IS_IN ? 1.0f : n0_ < 1536 ? 0.08838834764831845f * 1.4426950408889634f : (n0_ >= 5120 && n0_ < 5632) ? 0.08838834764831845f : 1.0f; \
        _Pragma("unroll") for (int i_ = 0; i_ < 8; ++i_) { const int idx_ = tid + 512 * i_, r_ = idx_ >> 6, c_ = idx_ & 63; f_[i_] = W[(unsigned)((k0_ + r_) * N + perm_logical(n0_ + c_, rp_))] * sc_; } } while (0)
#define TT_STEP(f_, tt_, ttn_) do { const int k02_ = ((tt_) & ((1 << ktl) - 1)) * 64, n02_ = ((tt_) >> ktl) * 64; \
        _Pragma("unroll") for (int i_ = 0; i_ < 8; ++i_) { const int idx_ = tid + 512 * i_; tile[(idx_ >> 6) * 65 + (idx_ & 63)] = f_[i_]; } \
        __syncthreads(); \
        TT_LOAD(f_, ttn_); \
        _Pragma("unroll") for (int i_ = 0; i_ < 4; ++i_) { const int idx_ = tid + 512 * i_, nn_ = idx_ >> 5, kk_ = (idx_ & 31) * 2; \
            *(unsigned*)(Wt + (unsigned)((n02_ + nn_) * K + k02_ + kk_)) = cvt_pk_bf16(tile[kk_ * 65 + nn_], tile[(kk_ + 1) * 65 + nn_]); } \
        __syncthreads(); } while (0)
    const int G = (int)gridDim.x; int tt = (int)blockIdx.x;
    TT_LOAD(fa, tt); TT_LOAD(fb, tt + G);
    for (; tt < ntiles; tt += 2 * G) {
        TT_STEP(fa, tt, tt + 2 * G);
        if (tt + G < ntiles) TT_STEP(fb, tt + G, tt + 3 * G);
    }
#undef TT_LOAD
#undef TT_STEP
}

__device__ __forceinline__ void phase_prep(const Params& p, LAS unsigned char* lds, const int tid0) {
    const int tid = tid0;
    LAS float* fl = (LAS float*)lds;
    constexpr int N_MOD = 384, N_TW = 16 * 152, N_TA = 8 * 16, N_TR = 16 * 16, N_TM = 16 * 16, N_TP = 16 * 32, N_KEY = 64, N_ROPE = 1024;
    constexpr int O_TW = N_MOD, O_TA = O_TW + N_TW, O_TR = O_TA + N_TA, O_TM = O_TR + N_TR, O_TP = O_TM + N_TM, O_KEY = O_TP + N_TP, O_ROPE = O_KEY + N_KEY, N_ALL = O_ROPE + N_ROPE;
    tt_run<true >(p.w_in,  (bf16_t*)(p.ws + WS_WIN_T), 1024, IN_W, 4, N_TW, fl, tid0);
    tt_run<false>(p.w_pq,  (bf16_t*)(p.ws + WS_WPQ_T), 1024, 2048, 4, N_TP, fl, tid0);
    tt_run<false>(p.w_ret, (bf16_t*)(p.ws + WS_WR_T),  1024, 1024, 4, N_TR, fl, tid0);
    tt_run<false>(p.w_mix, (bf16_t*)(p.ws + WS_WMX_T), 1024, 1024, 4, N_TM, fl, tid0);
    tt_run<false>(p.w_att, (bf16_t*)(p.ws + WS_WA_T),   512, 1024, 3, N_TA, fl, tid0);
    constexpr int P_KEY = N_MOD, P_ROPE = P_KEY + N_KEY, P_ALL = P_ROPE + N_ROPE;
    for (int item = blockIdx.x; item < P_ALL; item += gridDim.x) {
        if (item < P_KEY) {
            LAS float* sc = fl;
            LAS float* red = fl + 4096;
            for (int i = tid; i < 4096; i += 512) { const float v = p.c[i]; sc[i] = v * sigmoidf_(v); }
            __syncthreads();
            const int cc = tid & 15, col = item * 16 + cc, kg = tid >> 4;
            float wv[32];
#pragma unroll
            for (int k = 0; k < 32; ++k) wv[k] = p.w_ada[(size_t)(kg * 32 + k) * 6144 + col];
            float a0 = 0.f, a1 = 0.f, a2 = 0.f, a3 = 0.f;
#pragma unroll
            for (int k = 0; k < 32; ++k) { const int kk = kg * 32 + k; const float w = wv[k]; a0 += sc[kk] * w; a1 += sc[1024 + kk] * w; a2 += sc[2048 + kk] * w; a3 += sc[3072 + kk] * w; }
            red[(kg * 4 + 0) * 16 + cc] = a0; red[(kg * 4 + 1) * 16 + cc] = a1; red[(kg * 4 + 2) * 16 + cc] = a2; red[(kg * 4 + 3) * 16 + cc] = a3;
            __syncthreads();
            if (tid < 64) { const int b = tid >> 4, c2 = tid & 15; float s = 0.f;
#pragma unroll
                for (int g = 0; g < 32; ++g) s += red[(g * 4 + b) * 16 + c2];
                ((float*)(p.ws + WS_MOD))[b * 6144 + item * 16 + c2] = s + p.b_ada[item * 16 + c2]; }
            __syncthreads();
        } else if (item < P_ROPE) { const int t = item - P_KEY;
            const float* src = t < 32 ? p.keys1 : p.keys2; const int base = (t & 31) * 4096 + tid * 8;
            const f32x4 a = *(const f32x4*)(src + base), b = *(const f32x4*)(src + base + 4);
            u32x4 w; w.x = cvt_pk_bf16(a[0], a[1]); w.y = cvt_pk_bf16(a[2], a[3]); w.z = cvt_pk_bf16(b[0], b[1]); w.w = cvt_pk_bf16(b[2], b[3]);
            *(u32x4*)((bf16_t*)(p.ws + WS_KEYS) + (size_t)(t >> 5) * 131072 + base) = w;
        } else { const int t = item - P_ROPE;
            unsigned* rope = (unsigned*)(p.ws + WS_ROPE);
#pragma unroll
            for (int i = 0; i < 4; ++i) { const int e = t * 2048 + i * 512 + tid, tok = e >> 6, dd = e & 63;
                const double inv = exp2(-(double)dd * (13.287712379549449 / 64.0));
                double rev = (double)p.pos[tok] * inv * 0.15915494309189535; rev -= rint(rev);
                const float rf = (float)rev;
                rope[e] = cvt_pk_bf16_t(__builtin_amdgcn_cosf(rf), __builtin_amdgcn_sinf(rf)); }
        }
    }
}

__device__ __forceinline__ void phase_h(const Params& p, const int tid0) {
    const int lane = tid0 & 63, w = tid0 >> 6;
    const float* mod = (const float*)(p.ws + WS_MOD);
    bf16_t* h = (bf16_t*)((unsigned char*)p.out + DO_H);
    const int stride = gridDim.x * 8;
    int row = blockIdx.x * 8 + w;
    f32x4 v[4], vn[4], pA[4], pB[4]; int curb = -1;
#define PH_LOAD(dst, r_) do { const int rr_ = (r_) < T ? (r_) : T - 1; _Pragma("unroll") for (int i_ = 0; i_ < 4; ++i_) dst[i_] = __builtin_nontemporal_load((const f32x4*)(p.x + (size_t)rr_ * DM + i_ * 256 + lane * 4)); } while (0)
    PH_LOAD(v, row);
    for (; row < T; row += stride) {
        PH_LOAD(vn, row + stride);
        const int b = row / SEQ;
        if (b != curb) {
            curb = b;
#pragma unroll
            for (int i = 0; i < 4; ++i) { const int c = i * 256 + lane * 4; const f32x4 g = *(const f32x4*)(p.g_pre_mix + c), sc = *(const f32x4*)(mod + b * 6144 + 1024 + c); pB[i] = *(const f32x4*)(mod + b * 6144 + c);
#pragma unroll
                for (int j = 0; j < 4; ++j) pA[i][j] = g[j] * (1.0f + sc[j]); }
        }
        float ss = 0.f;
#pragma unroll
        for (int i = 0; i < 4; ++i) ss += v[i][0] * v[i][0] + v[i][1] * v[i][1] + v[i][2] * v[i][2] + v[i][3] * v[i][3];
        ss = wave_sum(ss);
        const float rstd = rsqrtf(ss * (1.0f / DM) + NORM_EPS);
#pragma unroll
        for (int i = 0; i < 4; ++i) { const int c = i * 256 + lane * 4;
            float o[4];
#pragma unroll
            for (int j = 0; j < 4; ++j) o[j] = v[i][j] * rstd * pA[i][j] + pB[i][j];
            u32x2 wv; wv.x = cvt_pk_bf16(o[0], o[1]); wv.y = cvt_pk_bf16(o[2], o[3]);
            *(u32x2*)(h + (size_t)row * DM + c) = wv; }
#pragma unroll
        for (int i = 0; i < 4; ++i) v[i] = vn[i];
    }
#undef PH_LOAD
}

__device__ __forceinline__ void phase_attn(const Params& p, LAS unsigned char* lds, const int tid0) {
    const int tid = tid0, lane = tid & 63, w = tid >> 6, l15 = lane & 15, g4 = lane >> 4;
    LAS unsigned char* Ks = lds;
    LAS unsigned char* Vs = lds + 256 * 272;
    const bf16_t* aq = (const bf16_t*)(p.ws + WS_AQ); const bf16_t* ak = (const bf16_t*)(p.ws + WS_AK); const bf16_t* av = (const bf16_t*)(p.ws + WS_AV);
    bf16_t* og = (bf16_t*)(p.ws + WS_OG); float* lse = (float*)(p.ws + WS_LSE);
    u32x4 kst[8], vst[8]; bf16x8 qn[4];
#define AT_FETCH(item_) do { const int it_ = (item_) < 3072 ? (item_) : 3071; const int b_ = it_ / 768, rem_ = it_ - b_ * 768, h12_ = rem_ >> 6, qb_ = rem_ & 63, dsh_ = (h12_ >> 2) * 2, dil_ = 1 << dsh_, r_ = qb_ & (dil_ - 1), n_ = qb_ >> dsh_; \
        const size_t hb_ = (size_t)(b_ * 12 + h12_) * SEQ + ((size_t)r_ << (13 - dsh_));       \
          \
        _Pragma("unroll") for (int kk_ = 0; kk_ < 4; ++kk_) qn[kk_] = *(const bf16x8*)(aq + (hb_ + (size_t)(128 * n_ + 16 * w + l15)) * 128 + 32 * kk_ + 8 * g4); \
        _Pragma("unroll") for (int i_ = 0; i_ < 8; ++i_) { const int c_ = tid + 512 * i_, row_ = c_ >> 4, ch_ = c_ & 15; const int m_ = 128 * (n_ - 1) + row_; \
            const size_t off_ = (hb_ + (size_t)(m_ < 0 ? 0 : m_)) * 128 + ch_ * 8; const u32x4 kq_ = *(const u32x4*)(ak + off_), vq_ = *(const u32x4*)(av + off_); \
            kst[i_] = m_ >= 0 ? kq_ : (u32x4){0u, 0u, 0u, 0u}; vst[i_] = m_ >= 0 ? vq_ : (u32x4){0u, 0u, 0u, 0u}; } (void)dil_; } while (0)
    const bool xmap = gridDim.x == 256;
    const int it0 = xmap ? (int)(blockIdx.x & 7) * 384 + (int)(blockIdx.x >> 3) : (int)blockIdx.x, itstep = xmap ? 32 : (int)gridDim.x, itend = xmap ? (int)(blockIdx.x & 7) * 384 + 384 : 3072;
    AT_FETCH(it0);
    for (int item = it0; item < itend; item += itstep) {
        const int b = item / 768, rem = item - b * 768, h12 = rem >> 6, qb = rem & 63, grp = h12 >> 2, hh = h12 & 3;
        const int dsh = grp * 2, dil = 1 << dsh, r = qb & (dil - 1), n = qb >> dsh;
        const size_t tb = (size_t)b * SEQ;
        const int i = 16 * w + l15;
        const size_t tq = tb + (size_t)(128 * n + i) * dil + r;
#pragma unroll
        for (int it = 0; it < 8; ++it) { const int c = tid + 512 * it, row = c >> 4, ch = c & 15; *(LAS u32x4*)(Ks + row * 272 + ch * 16) = kst[it]; *(LAS u32x4*)(Vs + row * 288 + ch * 16) = vst[it]; }
        bf16x8 qf[4];
#pragma unroll
        for (int kk = 0; kk < 4; ++kk) qf[kk] = qn[kk];
        asm volatile("" : "+v"(qf[0]), "+v"(qf[1]), "+v"(qf[2]), "+v"(qf[3]));
        __syncthreads();
        AT_FETCH(item + itstep);
        __builtin_amdgcn_sched_barrier(0);
        const int kt0 = w < 6 ? w : 6;
        f32x4 sacc[10];
        {
            bf16x8 ka[8], kb[8];
            const LAS unsigned char* kbase = Ks + (16 * kt0 + l15) * 272 + (8 * g4) * 2;
#define AT_KLD(dst, tp) do { _Pragma("unroll") for (int u_ = 0; u_ < 8; ++u_) dst[u_] = *(const LAS bf16x8*)(kbase + (2 * (tp) + (u_ >> 2)) * (16 * 272) + (u_ & 3) * 64); } while (0)
#define AT_KMM(src, tp) do { _Pragma("unroll") for (int h_ = 0; h_ < 2; ++h_) { f32x4 a4_ = {0.f, 0.f, 0.f, 0.f}; _Pragma("unroll") for (int kk_ = 0; kk_ < 4; ++kk_) a4_ = __builtin_amdgcn_mfma_f32_16x16x32_bf16(src[4 * h_ + kk_], qf[kk_], a4_, 0, 0, 0); sacc[2 * (tp) + h_] = a4_; } } while (0)
            AT_KLD(ka, 0); AT_KLD(kb, 1);
            __builtin_amdgcn_sched_barrier(0);
            AT_KMM(ka, 0); AT_KLD(ka, 2);
            __builtin_amdgcn_sched_barrier(0);
            AT_KMM(kb, 1); AT_KLD(kb, 3);
            __builtin_amdgcn_sched_barrier(0);
            AT_KMM(ka, 2); AT_KLD(ka, 4);
            __builtin_amdgcn_sched_barrier(0);
            AT_KMM(kb, 3);
            AT_KMM(ka, 4);
#undef AT_KLD
#undef AT_KMM
        }
        float mx = -1e30f;
#pragma unroll
        for (int t = 0; t < 10; ++t)
#pragma unroll
            for (int rg = 0; rg < 4; ++rg) { const int jj = 16 * (kt0 + t) + 4 * g4 + rg; const bool valid = (jj >= i) && (jj <= i + 128) && (n > 0 || jj >= 128);
                const float s = valid ? sacc[t][rg] : -1e30f; sacc[t][rg] = s; mx = fmaxf(mx, s); }
        mx = fmaxf(mx, __shfl_xor(mx, 16)); mx = fmaxf(mx, __shfl_xor(mx, 32));
        float sum = 0.f;
#pragma unroll
        for (int t = 0; t < 10; ++t)
#pragma unroll
            for (int rg = 0; rg < 4; ++rg) { const float e = fast_exp2(sacc[t][rg] - mx); sacc[t][rg] = e; sum += e; }
        sum += __shfl_xor(sum, 16); sum += __shfl_xor(sum, 32);
        f32x4 oacc[8];
#pragma unroll
        for (int et = 0; et < 8; ++et) oacc[et] = (f32x4){0.f, 0.f, 0.f, 0.f};
#pragma unroll
        for (int s5 = 0; s5 < 5; ++s5) {
            u32x4 pw; pw.x = cvt_pk_bf16_t(sacc[2 * s5][0], sacc[2 * s5][1]); pw.y = cvt_pk_bf16_t(sacc[2 * s5][2], sacc[2 * s5][3]);
            pw.z = cvt_pk_bf16_t(sacc[2 * s5 + 1][0], sacc[2 * s5 + 1][1]); pw.w = cvt_pk_bf16_t(sacc[2 * s5 + 1][2], sacc[2 * s5 + 1][3]);
            const bf16x8 pf = __builtin_bit_cast(bf16x8, pw);
            const LAS unsigned char* vb = Vs + (16 * (kt0 + 2 * s5) + 4 * g4 + (l15 >> 2)) * 288 + 16 * (l15 & 3);
#pragma unroll
            for (int et = 0; et < 8; ++et) { const s16x4 lo = lds_tr(vb + (et >> 1) * 64 + (et & 1) * 8), hi = lds_tr(vb + (et >> 1) * 64 + (et & 1) * 8 + 16 * 288);
                oacc[et] = __builtin_amdgcn_mfma_f32_16x16x32_bf16(cat8(lo, hi), pf, oacc[et], 0, 0, 0); }
        }
        const float inv = __builtin_amdgcn_rcpf(sum);
        bf16_t* op = og + (size_t)grp * T * 512 + tq * 512 + hh * 128 + 8 * g4;
#pragma unroll
        for (int u = 0; u < 4; ++u) { u32x4 wv; wv.x = cvt_pk_bf16(oacc[2 * u][0] * inv, oacc[2 * u][1] * inv); wv.y = cvt_pk_bf16(oacc[2 * u][2] * inv, oacc[2 * u][3] * inv);
            wv.z = cvt_pk_bf16(oacc[2 * u + 1][0] * inv, oacc[2 * u + 1][1] * inv); wv.w = cvt_pk_bf16(oacc[2 * u + 1][2] * inv, oacc[2 * u + 1][3] * inv); *(u32x4*)(op + u * 32) = wv; }
        if (g4 == 0) lse[(size_t)grp * T * 4 + tq * 4 + hh] = mx * 0.6931471805599453f + __logf(sum);
        __syncthreads();
    }
#undef AT_FETCH
}

__device__ __forceinline__ void phase_combine(const Params& p, const int tid0) {
    const bf16_t* og = (const bf16_t*)(p.ws + WS_OG); const float* lse = (const float*)(p.ws + WS_LSE);
    bf16_t* ya = (bf16_t*)((unsigned char*)p.out + DO_YATT);
    const int N = T * 64, step = (int)gridDim.x * 512;
    float l0n, l1n, l2n; u32x4 an, bn, cn;
#define CB_LOAD(i_) do { const int ii_ = (i_) < N ? (i_) : N - 1; const int t_ = ii_ >> 6, hh_ = (ii_ & 63) >> 4; const size_t o_ = (size_t)t_ * 512 + (ii_ & 63) * 8; \
        l0n = lse[(size_t)t_ * 4 + hh_]; l1n = lse[(size_t)T * 4 + (size_t)t_ * 4 + hh_]; l2n = lse[(size_t)T * 8 + (size_t)t_ * 4 + hh_]; \
        an = *(const u32x4*)(og + o_); bn = *(const u32x4*)(og + (size_t)T * 512 + o_); cn = *(const u32x4*)(og + (size_t)T * 1024 + o_); } while (0)
    int idx = blockIdx.x * 512 + tid0;
    if (idx < N) CB_LOAD(idx);
    for (; idx < N; idx += step) {
        const float l0 = l0n, l1 = l1n, l2 = l2n; const u32x4 a = an, bq = bn, cq = cn;
        CB_LOAD(idx + step);
        const int t = idx >> 6, c8 = idx & 63;
        const float m = fmaxf(l0, fmaxf(l1, l2)); float w0 = __expf(l0 - m), w1 = __expf(l1 - m), w2 = __expf(l2 - m); const float iv = __builtin_amdgcn_rcpf(w0 + w1 + w2); w0 *= iv; w1 *= iv; w2 *= iv;
        const size_t o = (size_t)t * 512 + c8 * 8;
        u32x4 r;
#pragma unroll
        for (int j = 0; j < 4; ++j) { const float lo = w0 * bf_lo(a[j]) + w1 * bf_lo(bq[j]) + w2 * bf_lo(cq[j]), hi = w0 * bf_hi(a[j]) + w1 * bf_hi(bq[j]) + w2 * bf_hi(cq[j]); r[j] = cvt_pk_bf16(lo, hi); }
        *(u32x4*)(ya + o) = r;
    }
#undef CB_LOAD
}

__device__ __forceinline__ float ret_log2g(int h) { return __log2f(1.0f - fast_exp2(-5.0f - (float)h)); }

__device__ __forceinline__ void phase_kv(const Params& p, LAS unsigned char* lds, const int tid0) {
    const int tid = tid0, lane = tid & 63, w = tid >> 6, l15 = lane & 15, g4 = lane >> 4;
    LAS unsigned char* Ks = lds;
    LAS unsigned char* Vs = lds + 128 * 288;
    const bf16_t* rk = (const bf16_t*)(p.ws + WS_RK); const bf16_t* rv = (const bf16_t*)(p.ws + WS_RV);
    bf16_t* kv = (bf16_t*)(p.ws + WS_KV);
    for (int item = blockIdx.x; item < 1024; item += gridDim.x) {
        const int n = item & 63, bh = item >> 6, h = bh & 3, b = bh >> 2;
        const size_t tok0 = (size_t)b * SEQ + 128 * n;
        const float lg = ret_log2g(h);
#pragma unroll
        for (int it = 0; it < 4; ++it) { const int c = tid + 512 * it, j = c >> 4, ch = c & 15;
            const u32x4 q = *(const u32x4*)(rk + (tok0 + j) * RET_QK_W + h * 128 + ch * 8); const float z = fast_exp2((float)(127 - j) * lg);
            u32x4 o;
#pragma unroll
            for (int e = 0; e < 4; ++e) o[e] = cvt_pk_bf16(bf_lo(q[e]) * z, bf_hi(q[e]) * z);
            *(LAS u32x4*)(Ks + j * 288 + ch * 16) = o; }
#pragma unroll
        for (int it = 0; it < 8; ++it) { const int c = tid + 512 * it, j = c >> 5, ch = c & 31;
            *(LAS u32x4*)(Vs + j * 544 + ch * 16) = *(const u32x4*)(rv + (tok0 + j) * RET_V_W + h * 256 + ch * 8); }
        __syncthreads();
        f32x4 acc[2][8];
#pragma unroll
        for (int a = 0; a < 2; ++a)
#pragma unroll
            for (int d = 0; d < 8; ++d) acc[a][d] = (f32x4){0.f, 0.f, 0.f, 0.f};
#pragma unroll
        for (int kk = 0; kk < 4; ++kk) {
            const int rowb = 32 * kk + 4 * g4 + (l15 >> 2), colb = (4 * (l15 & 3)) * 2;
            bf16x8 af[2];
#pragma unroll
            for (int a = 0; a < 2; ++a) { const LAS unsigned char* vb = Vs + rowb * 544 + (2 * w + a) * 32 + colb; af[a] = cat8(lds_tr(vb), lds_tr(vb + 16 * 544)); }
#pragma unroll
            for (int d = 0; d < 8; ++d) { const LAS unsigned char* kb = Ks + rowb * 288 + d * 32 + colb; const bf16x8 bfr = cat8(lds_tr(kb), lds_tr(kb + 16 * 288));
#pragma unroll
                for (int a = 0; a < 2; ++a) acc[a][d] = __builtin_amdgcn_mfma_f32_16x16x32_bf16(bfr, af[a], acc[a][d], 0, 0, 0); }
        }
        bf16_t* dst = kv + (size_t)item * 32768;
        float one = 1.0f; asm volatile("" : "+v"(one));
#pragma unroll
        for (int a = 0; a < 2; ++a)
#pragma unroll
            for (int d = 0; d < 8; ++d) { u32x2 wv; wv.x = cvt_pk_bf16(acc[a][d][0] * one, acc[a][d][1] * one); wv.y = cvt_pk_bf16(acc[a][d][2] * one, acc[a][d][3] * one);
                *(u32x2*)(dst + (16 * (2 * w + a) + l15) * 128 + 16 * d + 4 * g4) = wv; }
        __syncthreads();
    }
}

__device__ __forceinline__ void phase_scan(const Params& p, const int tid0) {
    const bf16_t* __restrict__ kv = (const bf16_t*)(p.ws + WS_KV);
    bf16_t* __restrict__ rprev = (bf16_t*)((unsigned char*)p.out + DO_RPREV);
    for (int idx = blockIdx.x * 512 + tid0; idx < 16 * 8192; idx += gridDim.x * 512) {
        const int bh = idx >> 13, within = idx & 8191, h = bh & 3;
        const float gd = fast_exp2(128.0f * ret_log2g(h));
        f32x4 st = {0.f, 0.f, 0.f, 0.f};
        const size_t base = (size_t)bh * 64 * 32768 + (size_t)within * 4;
        u32x2 ka[8], kb[8];
#define SC_LOAD(dst, n0_) do { _Pragma("unroll") for (int u_ = 0; u_ < 8; ++u_) dst[u_] = __builtin_nontemporal_load((const u32x2*)(kv + base + (size_t)((n0_) + u_) * 32768)); } while (0)
#define SC_FOLD(src, n0_) do { _Pragma("unroll") for (int u_ = 0; u_ < 8; ++u_) { u32x2 wv_; wv_.x = cvt_pk_bf16(st[0], st[1]); wv_.y = cvt_pk_bf16(st[2], st[3]); \
            *(u32x2*)(rprev + base + (size_t)((n0_) + u_) * 32768) = wv_; st = st * gd + (f32x4){bf_lo(src[u_].x), bf_hi(src[u_].x), bf_lo(src[u_].y), bf_hi(src[u_].y)}; } } while (0)
        SC_LOAD(ka, 0);
#pragma unroll 1
        for (int n = 0; n < 64; n += 16) {
            SC_LOAD(kb, n + 8);
            __builtin_amdgcn_sched_barrier(0);
            SC_FOLD(ka, n);
            if (n + 16 < 64) SC_LOAD(ka, n + 16);
            __builtin_amdgcn_sched_barrier(0);
            SC_FOLD(kb, n + 8);
        }
#undef SC_LOAD
#undef SC_FOLD
    }
}

__device__ __forceinline__ void phase_ret(const Params& p, LAS unsigned char* lds, const int tid0) {
    const int tid = tid0, lane = tid & 63, w = __builtin_amdgcn_readfirstlane(tid >> 6), l15 = lane & 15, g4 = lane >> 4;
    LAS unsigned char* Ks = lds;
    LAS unsigned char* Bs = lds + 128 * 272;
    const bf16_t* rq = (const bf16_t*)(p.ws + WS_RQ); const bf16_t* rk = (const bf16_t*)(p.ws + WS_RK); const bf16_t* rv = (const bf16_t*)(p.ws + WS_RV); const bf16_t* srg = (const bf16_t*)(p.ws + WS_RG);
    const bf16_t* rprev = (const bf16_t*)((const unsigned char*)p.out + DO_RPREV);
    bf16_t* ro = (bf16_t*)(p.ws + WS_RO);
    u32x4 kst[4], rst[8], vst[8];
#define RT_FETCH_KR(item_) do { const int it_ = (item_) < 1024 ? (item_) : 1023; const int n_ = it_ & 63, bh_ = it_ >> 6, h_ = bh_ & 3, b_ = bh_ >> 2; const size_t tk_ = (size_t)b_ * SEQ + 128 * n_; \
        _Pragma("unroll") for (int i_ = 0; i_ < 4; ++i_) { const int c_ = tid + 512 * i_, j_ = c_ >> 4, ch_ = c_ & 15; kst[i_] = *(const u32x4*)(rk + (tk_ + j_) * RET_QK_W + h_ * 128 + ch_ * 8); } \
        _Pragma("unroll") for (int i_ = 0; i_ < 8; ++i_) { const int c_ = tid + 512 * i_; rst[i_] = *(const u32x4*)(rprev + (size_t)it_ * 32768 + (size_t)c_ * 8); } } while (0)
    RT_FETCH_KR(blockIdx.x);
    for (int item = blockIdx.x; item < 1024; item += gridDim.x) {
        const int n = item & 63, bh = item >> 6, h = bh & 3, b = bh >> 2;
        const size_t tok0 = (size_t)b * SEQ + 128 * n;
        const float lg = ret_log2g(h);
#pragma unroll
        for (int it = 0; it < 4; ++it) { const int c = tid + 512 * it, j = c >> 4, ch = c & 15; *(LAS u32x4*)(Ks + j * 272 + ch * 16) = kst[it]; }
#pragma unroll
        for (int it = 0; it < 8; ++it) { const int c = tid + 512 * it, e = c >> 4, ch = c & 15; *(LAS u32x4*)(Bs + e * 272 + ch * 16) = rst[it]; }
#pragma unroll
        for (int it = 0; it < 8; ++it) { const int c = tid + 512 * it, j = c >> 5, ch = c & 31; vst[it] = *(const u32x4*)(rv + (tok0 + j) * RET_V_W + h * 256 + ch * 8); }
        const int i = 16 * w + l15; const size_t tq = tok0 + i;
        bf16x8 qf[4];
#pragma unroll
        for (int kk = 0; kk < 4; ++kk) qf[kk] = *(const bf16x8*)(rq + tq * RET_QK_W + h * 128 + 32 * kk + 8 * g4);
        __syncthreads();
        f32x4 acc[16];
#pragma unroll
        for (int et = 0; et < 16; ++et) acc[et] = (f32x4){0.f, 0.f, 0.f, 0.f};
        {
            const LAS unsigned char* rb = Bs + (8 * (l15 >> 2) + (l15 & 3)) * 272 + (8 * g4) * 2;
            bf16x8 ra[8], rbf[8];
#define RT_LD(dst, bt) do { _Pragma("unroll") for (int u_ = 0; u_ < 8; ++u_) dst[u_] = *(const LAS bf16x8*)(rb + (bt) * (32 * 272) + (u_ >> 2) * (4 * 272) + (u_ & 3) * 64); } while (0)
#define RT_MM(src, bt) do { _Pragma("unroll") for (int u_ = 0; u_ < 8; ++u_) acc[2 * (bt) + (u_ >> 2)] = __builtin_amdgcn_mfma_f32_16x16x32_bf16(src[u_], qf[u_ & 3], acc[2 * (bt) + (u_ >> 2)], 0, 0, 0); } while (0)
            RT_LD(ra, 0); RT_LD(rbf, 1);
#pragma unroll
            for (int bt = 0; bt < 8; bt += 2) {
                __builtin_amdgcn_sched_barrier(0);
                RT_MM(ra, bt); if (bt + 2 < 8) RT_LD(ra, bt + 2);
                __builtin_amdgcn_sched_barrier(0);
                RT_MM(rbf, bt + 1); if (bt + 3 < 8) RT_LD(rbf, bt + 3);
            }
#undef RT_LD
#undef RT_MM
        }
        const float xi = fast_exp2((float)(i + 1) * lg);
#pragma unroll
        for (int et = 0; et < 16; ++et) acc[et] = acc[et] * xi;
        bf16x8 pf[4];
#pragma unroll
        for (int s4 = 0; s4 < 4; ++s4) {
            u32x4 pw = {0u, 0u, 0u, 0u};
            if (2 * s4 <= w) {
                float pv[2][4];
#pragma unroll
                for (int u = 0; u < 2; ++u) { const int kt = 2 * s4 + u; f32x4 a4 = {0.f, 0.f, 0.f, 0.f};
#pragma unroll
                    for (int kk = 0; kk < 4; ++kk) { const bf16x8 kf = *(const LAS bf16x8*)(Ks + (16 * kt + l15) * 272 + (32 * kk + 8 * g4) * 2); a4 = __builtin_amdgcn_mfma_f32_16x16x32_bf16(kf, qf[kk], a4, 0, 0, 0); }
#pragma unroll
                    for (int rg = 0; rg < 4; ++rg) { const int j = 16 * kt + 4 * g4 + rg; pv[u][rg] = (j <= i) ? a4[rg] * fast_exp2((float)(i - j) * lg) : 0.f; } }
                pw.x = cvt_pk_bf16(pv[0][0], pv[0][1]); pw.y = cvt_pk_bf16(pv[0][2], pv[0][3]); pw.z = cvt_pk_bf16(pv[1][0], pv[1][1]); pw.w = cvt_pk_bf16(pv[1][2], pv[1][3]);
            }
            pf[s4] = __builtin_bit_cast(bf16x8, pw);
        }
        __syncthreads();
#pragma unroll
        for (int it = 0; it < 8; ++it) { const int c = tid + 512 * it, j = c >> 5, ch = c & 31; *(LAS u32x4*)(Bs + j * 544 + ch * 16) = vst[it]; }
        RT_FETCH_KR(item + (int)gridDim.x);
        __builtin_amdgcn_sched_barrier(0);
        __syncthreads();
#pragma unroll
        for (int s4 = 0; s4 < 4; ++s4) {
            if (2 * s4 <= w) {
                const LAS unsigned char* vb = Bs + (32 * s4 + 4 * g4 + (l15 >> 2)) * 544 + 16 * (l15 & 3);
#pragma unroll
                for (int et = 0; et < 16; ++et) { const s16x4 lo = lds_tr(vb + (et >> 1) * 64 + (et & 1) * 8), hi = lds_tr(vb + (et >> 1) * 64 + (et & 1) * 8 + 16 * 544);
                    acc[et] = __builtin_amdgcn_mfma_f32_16x16x32_bf16(cat8(lo, hi), pf[s4], acc[et], 0, 0, 0); }
            }
        }
        float ss = 0.f;
#pragma unroll
        for (int et = 0; et < 16; ++et) ss += acc[et][0] * acc[et][0] + acc[et][1] * acc[et][1] + acc[et][2] * acc[et][2] + acc[et][3] * acc[et][3];
        ss += __shfl_xor(ss, 16); ss += __shfl_xor(ss, 32);
        const float rstd = rsqrtf(ss * (1.0f / 256.0f) + NORM_EPS);
        u32x4 gq[8];
#pragma unroll
        for (int u = 0; u < 8; ++u) gq[u] = *(const u32x4*)(srg + tq * RET_V_W + h * 256 + 32 * u + 8 * g4);
#pragma unroll
        for (int u = 0; u < 8; ++u) { const size_t o = tq * RET_V_W + h * 256 + 32 * u + 8 * g4; const f32x4 a0 = acc[2 * u], a1 = acc[2 * u + 1]; const u32x4 g = gq[u];
            u32x4 wv; wv.x = cvt_pk_bf16(a0[0] * rstd * bf_lo(g.x), a0[1] * rstd * bf_hi(g.x)); wv.y = cvt_pk_bf16(a0[2] * rstd * bf_lo(g.y), a0[3] * rstd * bf_hi(g.y));
            wv.z = cvt_pk_bf16(a1[0] * rstd * bf_lo(g.z), a1[1] * rstd * bf_hi(g.z)); wv.w = cvt_pk_bf16(a1[2] * rstd * bf_lo(g.w), a1[3] * rstd * bf_hi(g.w));
            *(u32x4*)(ro + o) = wv; }
        __syncthreads();
    }
#undef RT_FETCH_KR
}


__device__ __forceinline__ float wave_max(float v) { v = row16_max_f(v); v = fmaxf(v, __shfl_xor(v, 16)); v = fmaxf(v, __shfl_xor(v, 32)); return v; }
__device__ __forceinline__ unsigned pack_i8x4(float a, float b, float c, float d) {
    const int ia = (int)__builtin_rintf(a), ib = (int)__builtin_rintf(b), ic = (int)__builtin_rintf(c), id = (int)__builtin_rintf(d);
    return (unsigned)(ia & 0xff) | ((unsigned)(ib & 0xff) << 8) | ((unsigned)(ic & 0xff) << 16) | ((unsigned)(id & 0xff) << 24);
}
__device__ __forceinline__ unsigned pack_i8x4_scaled(float a, float b, float c, float d, float qs) {
    const unsigned fa = __float_as_uint(__builtin_fmaf(a, qs, 12582912.0f)), fb = __float_as_uint(__builtin_fmaf(b, qs, 12582912.0f)), fc = __float_as_uint(__builtin_fmaf(c, qs, 12582912.0f)), fd = __float_as_uint(__builtin_fmaf(d, qs, 12582912.0f));
    return __builtin_amdgcn_perm(fb, fa, 0x0c0c0400u) | __builtin_amdgcn_perm(fd, fc, 0x04000c0cu);
}
__device__ __forceinline__ void phase_rows(const Params& p, const int tid0) {
    const int lane = tid0 & 63, w = tid0 >> 6;
    const float* mod = (const float*)(p.ws + WS_MOD); const bf16_t* ym = (const bf16_t*)(p.ws + WS_YM);
    bf16_t* h2 = (bf16_t*)(p.ws + WS_H2); unsigned char* h2q = p.ws + WS_H2Q; float* sx = (float*)(p.ws + WS_SX); bf16_t* x1b = (bf16_t*)(p.ws + WS_X1B);
    const int rstride = gridDim.x * 8;
    u32x2 yq[4], yqn[4]; f32x4 xq[4], xqn[4]; f32x4 pG1[4], pA2[4], pB2[4]; int curb = -1;
#define PR_LOAD(yd, xd, r_) do { const int rr_ = (r_) < T ? (r_) : T - 1; _Pragma("unroll") for (int i_ = 0; i_ < 4; ++i_) { yd[i_] = __builtin_nontemporal_load((const u32x2*)(ym + (size_t)rr_ * DM + i_ * 256 + lane * 4)); xd[i_] = __builtin_nontemporal_load((const f32x4*)(p.x + (size_t)rr_ * DM + i_ * 256 + lane * 4)); } } while (0)
    PR_LOAD(yq, xq, blockIdx.x * 8 + w);
    for (int row = blockIdx.x * 8 + w; row < T; row += rstride) {
        PR_LOAD(yqn, xqn, row + rstride);
        const int b = row / SEQ;
        if (b != curb) {
            curb = b; const float* mb = mod + b * 6144;
#pragma unroll
            for (int i = 0; i < 4; ++i) { const int c = i * 256 + lane * 4;
                const f32x4 g1 = *(const f32x4*)(p.g_post_mix + c), gt = *(const f32x4*)(mb + 2048 + c), g2 = *(const f32x4*)(p.g_pre_ffn + c), sc = *(const f32x4*)(mb + 4096 + c); pB2[i] = *(const f32x4*)(mb + 3072 + c);
#pragma unroll
                for (int j = 0; j < 4; ++j) { pG1[i][j] = g1[j] * gt[j]; pA2[i][j] = g2[j] * (1.0f + sc[j]); } }
        }
        f32x4 v[4]; float ss = 0.f;
#pragma unroll
        for (int i = 0; i < 4; ++i) { const u32x2 q = yq[i]; v[i] = (f32x4){bf_lo(q.x), bf_hi(q.x), bf_lo(q.y), bf_hi(q.y)}; ss += v[i][0] * v[i][0] + v[i][1] * v[i][1] + v[i][2] * v[i][2] + v[i][3] * v[i][3]; }
        ss = wave_sum(ss);
        const float rstd = rsqrtf(ss * (1.0f / DM) + NORM_EPS);
        float s1 = 0.f;
#pragma unroll
        for (int i = 0; i < 4; ++i) { const int c = i * 256 + lane * 4;
            const f32x4 xv = xq[i];
#pragma unroll
            for (int j = 0; j < 4; ++j) { v[i][j] = xv[j] + pG1[i][j] * (v[i][j] * rstd); s1 += v[i][j] * v[i][j]; }
            u32x2 xw; xw.x = cvt_pk_bf16(v[i][0], v[i][1]); xw.y = cvt_pk_bf16(v[i][2], v[i][3]); *(u32x2*)(x1b + (size_t)row * DM + c) = xw; }
        s1 = wave_sum(s1);
        const float rstd1 = rsqrtf(s1 * (1.0f / DM) + NORM_EPS);
        float amax = 0.f;
#pragma unroll
        for (int i = 0; i < 4; ++i) { const int c = i * 256 + lane * 4;
#pragma unroll
            for (int j = 0; j < 4; ++j) { v[i][j] = v[i][j] * rstd1 * pA2[i][j] + pB2[i][j]; amax = fmaxf(amax, fabsf(v[i][j])); }
            u32x2 wv; wv.x = cvt_pk_bf16(v[i][0], v[i][1]); wv.y = cvt_pk_bf16(v[i][2], v[i][3]);
            *(u32x2*)(h2 + (size_t)row * DM + c) = wv; }
        amax = wave_max(amax);
        const float qs = amax > 0.f ? 127.0f * __builtin_amdgcn_rcpf(amax) : 0.f;
#pragma unroll
        for (int i = 0; i < 4; ++i) *(unsigned*)(h2q + (size_t)row * DM + i * 256 + lane * 4) = pack_i8x4(v[i][0] * qs, v[i][1] * qs, v[i][2] * qs, v[i][3] * qs);
        if (lane == 0) sx[row] = amax * (1.0f / 127.0f);
#pragma unroll
        for (int i = 0; i < 4; ++i) { yq[i] = yqn[i]; xq[i] = xqn[i]; }
    }
#undef PR_LOAD
}

__device__ __forceinline__ unsigned f2key(float f) { const unsigned u = __float_as_uint(f); return u ^ ((unsigned)((int)u >> 31) | 0x80000000u); }
__device__ __forceinline__ float key2f(unsigned k) { return __uint_as_float((k & 0x80000000u) ? (k ^ 0x80000000u) : ~k); }
#define RT_CS(a, b) do { const unsigned _h = (a) > (b) ? (a) : (b), _l = (a) > (b) ? (b) : (a); (a) = _h; (b) = _l; } while (0)
__device__ __forceinline__ void bmerge16(unsigned (&v)[16]) {
#pragma unroll
    for (int j = 8; j >= 1; j >>= 1)
#pragma unroll
        for (int i = 0; i < 16; ++i) { const int l = i ^ j; if (l > i) RT_CS(v[i], v[l]); }
}
__device__ __forceinline__ void bsort16(unsigned (&v)[16]) {
#pragma unroll
    for (int k = 2; k <= 16; k <<= 1)
#pragma unroll
        for (int j = k >> 1; j >= 1; j >>= 1)
#pragma unroll
            for (int i = 0; i < 16; ++i) { const int l = i ^ j; if (l > i) { if ((i & k) == 0) RT_CS(v[i], v[l]); else RT_CS(v[l], v[i]); } }
}
__device__ __forceinline__ void topmerge16(unsigned (&a)[16], const unsigned (&b)[16]) {
#pragma unroll
    for (int i = 0; i < 16; ++i) a[i] = a[i] > b[15 - i] ? a[i] : b[15 - i];
    bmerge16(a);
}

__device__ __forceinline__ void phase_route(const Params& p, LAS unsigned char* lds, const int tid0) {
    const int tid = tid0, lane = tid & 63, w = tid >> 6, l15 = lane & 15, g4 = lane >> 4;
    const bf16_t* qp = (const bf16_t*)(p.ws + WS_QP); const bf16_t* keys = (const bf16_t*)(p.ws + WS_KEYS);
    int* ids = (int*)(p.ws + WS_IDS); float* gates = (float*)(p.ws + WS_GT);
    LAS unsigned* tab = (LAS unsigned*)lds + w * 512;
    LAS unsigned char* kls = lds + 16384;
    unsigned char* dn = p.ws + WS_DN; unsigned char* up = p.ws + WS_UP; float* sdn = (float*)(p.ws + WS_SDN); float* sup = (float*)(p.ws + WS_SUP);
    const int tqstep = gridDim.x * 8; int tqr = __builtin_amdgcn_readfirstlane((int)blockIdx.x * 8 + w); f32x4 tqv[4];
#define TQ_LOAD() do { if (tqr < 32768) { const float* src_ = (tqr >= 16384 ? p.up + (size_t)(tqr - 16384) * DM : p.down + (size_t)tqr * DM); \
            unsigned lo_ = (unsigned)lane * 16u; asm volatile("" : "+v"(lo_)); \
            _Pragma("unroll") for (int i_ = 0; i_ < 4; ++i_) tqv[i_] = __builtin_nontemporal_load((const f32x4*)((const char*)src_ + i_ * 1024 + lo_)); } } while (0)
#define TQ_FIN() do { if (tqr < 32768) { const bool second_ = tqr >= 16384; const int row_ = second_ ? tqr - 16384 : tqr; float amax_ = 0.f; \
            _Pragma("unroll") for (int i_ = 0; i_ < 4; ++i_) amax_ = fmaxf(amax_, fmaxf(fmaxf(fabsf(tqv[i_][0]), fabsf(tqv[i_][1])), fmaxf(fabsf(tqv[i_][2]), fabsf(tqv[i_][3])))); \
            amax_ = wave_max(amax_); const float qs_ = amax_ > 0.f ? 127.0f * __builtin_amdgcn_rcpf(amax_) : 0.f; \
            unsigned so_ = second_ ? (unsigned)(lane >> 5) * 2097152u + (unsigned)(lane & 31) * 4u : (unsigned)lane * 4u; asm volatile("" : "+v"(so_)); \
            unsigned char* sb_ = second_ ? up + (size_t)row_ * 128 : dn + (size_t)row_ * DM;          \
            _Pragma("unroll") for (int i_ = 0; i_ < 4; ++i_) { const unsigned pk_ = pack_i8x4_scaled(tqv[i_][0], tqv[i_][1], tqv[i_][2], tqv[i_][3], qs_); \
                *(unsigned*)(sb_ + (second_ ? (size_t)i_ * 4194304 : (size_t)i_ * 256) + so_) = pk_; } \
            if (lane == 0) (second_ ? sup : sdn)[row_] = amax_ * (1.0f / 127.0f); tqr += tqstep; } } while (0)
    for (int blk = blockIdx.x; blk < T / 128; blk += gridDim.x) {
        const int tok = blk * 128 + w * 16 + l15;
        u32x4 kst[8]; bf16x8 qn[2][4];
#define RT_KLOAD(h_) do { const char* kb_ = (const char*)keys + (size_t)(h_) * 32768; unsigned kvo_ = (unsigned)tid * 16u; asm volatile("" : "+v"(kvo_));        \
            _Pragma("unroll") for (int i_ = 0; i_ < 8; ++i_) kst[i_] = *(const u32x4*)(kb_ + (size_t)(i_ >> 2) * 262144 + (size_t)(i_ & 3) * 8192 + kvo_); } while (0)
#define RT_KSTORE() do { _Pragma("unroll") for (int i_ = 0; i_ < 8; ++i_) { const int c_ = tid + 512 * i_; *(LAS u32x4*)(kls + (c_ >> 11) * 34816 + ((c_ >> 4) & 127) * 272 + (c_ & 15) * 16) = kst[i_]; } } while (0)
#define RT_QLOAD(h_) do { _Pragma("unroll") for (int hf_ = 0; hf_ < 2; ++hf_) _Pragma("unroll") for (int kk_ = 0; kk_ < 4; ++kk_) qn[hf_][kk_] = *(const bf16x8*)(qp + (size_t)tok * 2048 + (h_) * 256 + hf_ * 128 + 32 * kk_ + 8 * g4); } while (0)
        RT_KLOAD(0); RT_QLOAD(0);
        __syncthreads();
        RT_KSTORE();
#pragma unroll 1
        for (int h = 0; h < 8; ++h) {
            bf16x8 qf[2][4];
#pragma unroll
            for (int hf = 0; hf < 2; ++hf)
#pragma unroll
                for (int kk = 0; kk < 4; ++kk) qf[hf][kk] = qn[hf][kk];
            __syncthreads();
            if (h + 1 < 8) { RT_KLOAD(h + 1); RT_QLOAD(h + 1); }
            TQ_LOAD();
            unsigned vp[2][16];
#pragma unroll
            for (int half = 0; half < 2; ++half) {
                unsigned ta[16], tb[16];
#pragma unroll
                for (int nt = 0; nt < 8; ++nt) { f32x4 a4 = {0.f, 0.f, 0.f, 0.f};
#pragma unroll
                    for (int kk = 0; kk < 4; ++kk) { const bf16x8 kf = *(const LAS bf16x8*)(kls + half * 34816 + (16 * nt + l15) * 272 + (32 * kk + 8 * g4) * 2); a4 = __builtin_amdgcn_mfma_f32_16x16x32_bf16(kf, qf[half][kk], a4, 0, 0, 0); }
#pragma unroll
                    for (int rg = 0; rg < 4; ++rg) { const unsigned k = (f2key(a4[rg]) & ~0x7Fu) | (unsigned)(16 * nt + 4 * g4 + rg); if (nt < 4) ta[4 * nt + rg] = k; else tb[4 * (nt - 4) + rg] = k; } }
                bsort16(ta); bsort16(tb); topmerge16(ta, tb);
#pragma unroll
                for (int rnd = 16; rnd <= 32; rnd <<= 1) {
#pragma unroll
                    for (int j = 0; j < 16; ++j) tb[j] = (unsigned)__shfl_xor((int)ta[j], rnd);
                    topmerge16(ta, tb); }
#pragma unroll
                for (int j = 0; j < 16; ++j) vp[half][j] = ta[j];
            }
            TQ_FIN(); TQ_LOAD();
            float f1[16], f2[16];
#pragma unroll
            for (int j = 0; j < 16; ++j) { f1[j] = key2f(vp[0][j] & ~0x7Fu); f2[j] = key2f(vp[1][j] & ~0x7Fu); }
#define RT_CK(a, b) ((f2key(f1[a] + f2[b]) & ~0xFFu) | (unsigned)(255 - (16 * (a) + (b))))
            unsigned top[16], l1[16];
#pragma unroll
            for (int b = 0; b < 16; ++b) top[b] = RT_CK(0, b);
#pragma unroll
            for (int b = 0; b < 8; ++b) { l1[b] = RT_CK(1, b); l1[15 - b] = RT_CK(8 + b, 0); }
            bmerge16(l1); topmerge16(top, l1);
            l1[0] = RT_CK(2, 0); l1[1] = RT_CK(2, 1); l1[2] = RT_CK(2, 2); l1[3] = RT_CK(2, 3); l1[4] = RT_CK(2, 4); l1[5] = RT_CK(3, 0); l1[6] = RT_CK(3, 1); l1[7] = RT_CK(3, 2); l1[8] = RT_CK(3, 3);
            l1[9] = RT_CK(4, 0); l1[10] = RT_CK(4, 1); l1[11] = RT_CK(4, 2); l1[12] = RT_CK(5, 0); l1[13] = RT_CK(5, 1); l1[14] = RT_CK(6, 0); l1[15] = RT_CK(6, 1);
            bsort16(l1); topmerge16(top, l1);
            { const unsigned c0 = RT_CK(7, 0), c1 = RT_CK(7, 1);
              top[15] = top[15] > c0 ? top[15] : c0; top[14] = top[14] > c1 ? top[14] : c1; bmerge16(top); }
#undef RT_CK
            const float m = key2f(top[0]); float e[16], se = 0.f;
#pragma unroll
            for (int j = 0; j < 16; ++j) { e[j] = __expf(key2f(top[j]) - m); se += e[j]; }
            const float ise = __builtin_amdgcn_rcpf(se);
            __syncthreads();
            if (h + 1 < 8) RT_KSTORE();
            if (g4 == 0) {
#pragma unroll
                for (int j = 0; j < 16; ++j) { tab[l15 * 32 + j] = vp[0][j]; tab[l15 * 32 + 16 + j] = vp[1][j]; } }
            __builtin_amdgcn_fence(__ATOMIC_RELEASE, "workgroup"); __builtin_amdgcn_wave_barrier(); __builtin_amdgcn_fence(__ATOMIC_ACQUIRE, "workgroup");
            u32x4 idv; f32x4 gtv;
#pragma unroll
            for (int jj = 0; jj < 4; ++jj) {
                const unsigned k = g4 == 0 ? top[jj] : g4 == 1 ? top[4 + jj] : g4 == 2 ? top[8 + jj] : top[12 + jj];
                const float gt = (g4 == 0 ? e[jj] : g4 == 1 ? e[4 + jj] : g4 == 2 ? e[8 + jj] : e[12 + jj]) * ise;
                const unsigned ab = 255u - (k & 255u); const int a = (int)(ab >> 4), b = (int)(ab & 15u);
                const int i1 = tab[l15 * 32 + a] & 0x7F, i2 = tab[l15 * 32 + 16 + b] & 0x7F;
                idv[jj] = (unsigned)(i1 * 128 + i2); gtv[jj] = gt;
            }
            *(u32x4*)(ids + (size_t)tok * 128 + h * 16 + 4 * g4) = idv;
            *(f32x4*)(gates + (size_t)tok * 128 + h * 16 + 4 * g4) = gtv;
            TQ_FIN();
        }
    }
    while (tqr < 32768) { TQ_LOAD(); TQ_FIN(); }
#undef TQ_LOAD
#undef TQ_FIN
}

#undef RT_KLOAD
#undef RT_KSTORE
#undef RT_QLOAD
constexpr float DN_SCALE = 128.0f, UP_SCALE = 8.0f;
__device__ __forceinline__ float gelu_erf(float v) {
    const float av = fabsf(v), t = __builtin_amdgcn_rcpf(av * 0.2316418882f + 1.0f);
    float q = t * 0.5307027145f + (-0.7265760135f); q = q * t + 0.7107068705f; q = q * t + (-0.142248368f); q = q * t + 0.127414796f; q = q * t;
    const float e = __builtin_amdgcn_exp2f((v * v) * (-0.72134752044f));
    const float m = v * (q * e);
    return v < 0.f ? m : v - m;
}
__device__ __forceinline__ f32x2 fp8lo(unsigned w) { return __builtin_amdgcn_cvt_pk_f32_fp8((int)w, false); }
__device__ __forceinline__ f32x2 fp8hi(unsigned w) { return __builtin_amdgcn_cvt_pk_f32_fp8((int)w, true); }
struct SliceInfo { int rank, nloc, sidx, nx; };

template <int MODE> __device__ __forceinline__ void phase_xdown(const Params& p, LAS unsigned char* lds, const int tid0, const SliceInfo si) {
    const int lane = tid0 & 63, w = tid0 >> 6, l15 = lane & 15, r4 = lane >> 4;
    const unsigned char* h2q = p.ws + WS_H2Q; const float* sx = (const float*)(p.ws + WS_SX); const unsigned char* dn = p.ws + WS_DN;
    const float* sdn = (const float*)(p.ws + WS_SDN); const float* sup = (const float*)(p.ws + WS_SUP);
    const int* ids = (const int*)(p.ws + WS_IDS); const float* gates = (const float*)(p.ws + WS_GT); float* wout = (float*)(p.ws + WS_WB);
    LAS int* lstb = (LAS int*)lds + w * 1024;
    LAS unsigned char* stg = lds + 32768 + w * 12288;
    const int t0 = si.rank * 8 + w, tstride = si.nloc * 8;
    const int K = t0 < T ? (T - 1 - t0) / tstride + 1 : 0;
    for (int sl = si.sidx; sl < 8; sl += si.nx) {
        if (K == 0) continue;
        int rawI[4]; u32x4 xC[4], xN[4]; u32x4 bufA[4], bufB[4]; float sxC, sxN, sxb;
        int nC = 0, nN = 0;
        float fin_g = 0.f, fin_sd = 0.f, fin_su = 0.f, fin_sx = 0.f; int fin_slot = 0, fin_dot = 0, fin_n = 0, fin_tok = 0;
#define XD_TOK(k_) (t0 + ((k_) < K ? (k_) : K - 1) * tstride)
#define XD_BATCH(kb_) do { int bi_[6][4]; u32x4 bx_[6]; \
            _Pragma("unroll") for (int t_ = 0; t_ < 6; ++t_) { const int tk_ = XD_TOK((kb_) + t_); const size_t o_ = (size_t)tk_ * 128; bi_[t_][0] = *(ids + o_ + lane); bi_[t_][1] = *(ids + o_ + 64 + lane); \
                bi_[t_][2] = (int)__float_as_uint(*(gates + o_ + lane)); bi_[t_][3] = (int)__float_as_uint(*(gates + o_ + 64 + lane)); bx_[t_] = *(const u32x4*)(h2q + (size_t)tk_ * DM + lane * 16); } \
            sxb = sx[XD_TOK((kb_) + (lane < 6 ? lane : 5))]; \
            _Pragma("unroll") for (int t_ = 0; t_ < 6; ++t_) { LAS int* s_ = (LAS int*)(stg + t_ * 2048); s_[lane] = bi_[t_][0]; s_[64 + lane] = bi_[t_][1]; s_[128 + lane] = bi_[t_][2]; s_[192 + lane] = bi_[t_][3]; \
                *(LAS u32x4*)(stg + t_ * 2048 + 1024 + lane * 16) = bx_[t_]; } \
            __builtin_amdgcn_fence(__ATOMIC_RELEASE, "wavefront"); __builtin_amdgcn_wave_barrier(); __builtin_amdgcn_fence(__ATOMIC_ACQUIRE, "wavefront"); } while (0)
#define XD_LOADI(k_) do { const LAS int* s_ = (const LAS int*)(stg + ((k_) % 6) * 2048); rawI[0] = s_[lane]; rawI[1] = s_[64 + lane]; rawI[2] = s_[128 + lane]; rawI[3] = s_[192 + lane]; } while (0)
#define XD_LOADX(xx, sxx, k_) do { const int t_ = (k_) % 6; const LAS unsigned char* hp_ = stg + t_ * 2048 + 1024 + l15 * 16; _Pragma("unroll") for (int j_ = 0; j_ < 4; ++j_) xx[j_] = *((const LAS u32x4*)(hp_ + j_ * 256)); \
            sxx = __uint_as_float((unsigned)__builtin_amdgcn_readlane((int)__float_as_uint(sxb), t_)); } while (0)
#define XD_LIST(slot_, nout_) do { LAS int* l_ = lstb + (slot_) * 512; const bool inA_ = (rawI[0] >> 11) == sl, inB_ = (rawI[1] >> 11) == sl; \
            const unsigned long long mA_ = __ballot(inA_), mB_ = __ballot(inB_); const int nA_ = __popcll(mA_); nout_ = nA_ + __popcll(mB_); \
            const int rkA_ = __builtin_amdgcn_mbcnt_hi((unsigned)(mA_ >> 32), __builtin_amdgcn_mbcnt_lo((unsigned)mA_, 0u)); \
            const int rkB_ = nA_ + __builtin_amdgcn_mbcnt_hi((unsigned)(mB_ >> 32), __builtin_amdgcn_mbcnt_lo((unsigned)mB_, 0u)); \
            if (inA_) { l_[rkA_ * 4 + 0] = rawI[0]; l_[rkA_ * 4 + 1] = rawI[2]; l_[rkA_ * 4 + 2] = lane; } \
            if (inB_) { l_[rkB_ * 4 + 0] = rawI[1]; l_[rkB_ * 4 + 1] = rawI[3]; l_[rkB_ * 4 + 2] = 64 + lane; } \
            __builtin_amdgcn_fence(__ATOMIC_RELEASE, "wavefront"); __builtin_amdgcn_wave_barrier(); __builtin_amdgcn_fence(__ATOMIC_ACQUIRE, "wavefront"); } while (0)
#define XD_ISSUE(dd, slot_, n_, g_) do { const LAS int* l_ = lstb + (slot_) * 512; const int k_ = 4 * (g_) + r4; const int id_ = (MODE != 1 && k_ < (n_)) ? l_[k_ * 4] : sl * 2048; const unsigned char* rp_ = dn + (size_t)id_ * 1024 + l15 * 16; \
            _Pragma("unroll") for (int j_ = 0; j_ < 4; ++j_) dd[j_] = *(const u32x4*)(rp_ + j_ * 256); } while (0)
#define XD_MATH(dd, slot_, n_, g_) do { int a0_ = 0, a1_ = 0; \
            if (MODE == 2) { _Pragma("unroll") for (int j_ = 0; j_ < 4; ++j_) a0_ ^= (int)(dd[j_][0] ^ dd[j_][1] ^ dd[j_][2] ^ dd[j_][3]); } else { \
            _Pragma("unroll") for (int j_ = 0; j_ < 4; j_ += 2) _Pragma("unroll") for (int q_ = 0; q_ < 4; ++q_) { a0_ = __builtin_amdgcn_sdot4((int)dd[j_][q_], (int)xC[j_][q_], a0_, false); a1_ = __builtin_amdgcn_sdot4((int)dd[j_ + 1][q_], (int)xC[j_ + 1][q_], a1_, false); } } \
            const int d_ = row16_sum_i(a0_ + a1_); \
            LAS int* l_ = lstb + (slot_) * 512; const int k_ = 4 * (g_) + r4; if (k_ < (n_) && l15 == 0) l_[k_ * 4 + 3] = d_; } while (0)
#define XD_FIN_BEGIN(slot_, n_, tok_) do { __builtin_amdgcn_fence(__ATOMIC_RELEASE, "wavefront"); __builtin_amdgcn_wave_barrier(); __builtin_amdgcn_fence(__ATOMIC_ACQUIRE, "wavefront"); \
            const LAS int* l_ = lstb + (slot_) * 512; fin_n = (n_); fin_tok = (tok_); fin_sx = sxC; \
            if (lane < (n_)) { const int id_ = l_[lane * 4]; fin_g = __uint_as_float((unsigned)l_[lane * 4 + 1]); fin_slot = l_[lane * 4 + 2]; fin_dot = l_[lane * 4 + 3]; fin_sd = sdn[id_]; fin_su = sup[id_]; } \
            for (int e_ = 64 + lane; e_ < (n_); e_ += 64) { const int id_ = l_[e_ * 4]; wout[(size_t)(tok_) * 128 + l_[e_ * 4 + 2]] = __uint_as_float((unsigned)l_[e_ * 4 + 1]) * gelu_erf((float)l_[e_ * 4 + 3] * (sxC * sdn[id_])) * sup[id_]; } } while (0)
#define XD_FIN_END() do { if (lane < fin_n) wout[(size_t)fin_tok * 128 + fin_slot] = fin_g * gelu_erf((float)fin_dot * (fin_sx * fin_sd)) * fin_su; fin_n = 0; } while (0)
        XD_BATCH(0);
        XD_LOADI(0); XD_LOADX(xC, sxC, 0);
        XD_LIST(0, nC);
        XD_LOADI(1);
        XD_ISSUE(bufA, 0, nC, 0);
        int par = 0;
#pragma unroll 1
        for (int k = 0; k < K; ++k) {
            const int sC = k & 1, sN = sC ^ 1; const int tok = t0 + k * tstride;
            XD_LIST(sN, nN);
            XD_LOADX(xN, sxN, k + 1);
            if ((k + 2) % 6 == 0) XD_BATCH(k + 2);
            XD_LOADI(k + 2);
            const int ng = nC > 0 ? (nC + 3) >> 2 : 1;
#define XD_GROUPS(X_, Y_) do { int g_ = 0; \
                _Pragma("unroll 1") for (; g_ + 1 < ng; g_ += 2) { XD_ISSUE(Y_, sC, nC, g_ + 1); XD_MATH(X_, sC, nC, g_); if (g_ + 2 < ng) XD_ISSUE(X_, sC, nC, g_ + 2); else XD_ISSUE(X_, sN, nN, 0); XD_MATH(Y_, sC, nC, g_ + 1); } \
                if (ng & 1) { XD_ISSUE(Y_, sN, nN, 0); XD_MATH(X_, sC, nC, ng - 1); } } while (0)
            if (par == 0) XD_GROUPS(bufA, bufB); else XD_GROUPS(bufB, bufA);
#undef XD_GROUPS
            par ^= ng & 1;
            XD_FIN_END();
            XD_FIN_BEGIN(sC, nC, tok);
#pragma unroll
            for (int j = 0; j < 4; ++j) xC[j] = xN[j];
            sxC = sxN; nC = nN;
        }
        XD_FIN_END();
#undef XD_TOK
#undef XD_LOADI
#undef XD_BATCH
#undef XD_LOADX
#undef XD_LIST
#undef XD_ISSUE
#undef XD_MATH
#undef XD_FIN_BEGIN
#undef XD_FIN_END
    }
}

__device__ __forceinline__ void phase_xup(const Params& p, LAS unsigned char* lds, const int tid0, const SliceInfo si) {
    const int lane = tid0 & 63, w = tid0 >> 6, c8 = lane & 7, q8 = lane >> 3;
    const unsigned char* up = p.ws + WS_UP; const int* ids = (const int*)(p.ws + WS_IDS); const float* wts = (const float*)(p.ws + WS_WB);
    bf16_t* fbuf = (bf16_t*)(p.ws + WS_F); float* ssq = (float*)(p.ws + WS_SSQ);
    LAS int* slots = (LAS int*)lds + w * 512;
    const int t0 = si.rank * 8 + w, tstride = si.nloc * 8;
    const int K = t0 < T ? (T - 1 - t0) / tstride + 1 : 0;
    const bool b32 = (lane & 32) != 0, b16 = (lane & 16) != 0, b8 = (lane & 8) != 0;
    for (int sl = si.sidx; sl < 8; sl += si.nx) {
        if (K == 0) continue;
        int rawA[4], rawB[4]; u32x4 seg0[16], seg1[16]; float swv[2];
        const unsigned char* ups = up + (size_t)sl * 2097152;
#define XU_TOK(k_) (t0 + ((k_) < K ? (k_) : K - 1) * tstride)
#define XU_RAW(rr, k_) do { const size_t o_ = (size_t)XU_TOK(k_) * 128; rr[0] = *(ids + o_ + lane); rr[1] = *(ids + o_ + 64 + lane); \
            rr[2] = (int)__float_as_uint(*(wts + o_ + lane)); rr[3] = (int)__float_as_uint(*(wts + o_ + 64 + lane)); } while (0)
#define XU_LSTAGE(ss, rr, slot_) do { LAS int* s_ = slots + (slot_) * 256; const float wa_ = __uint_as_float((unsigned)rr[2]), wb_ = __uint_as_float((unsigned)rr[3]); \
            const float am_ = wave_max(fmaxf(fabsf(wa_), fabsf(wb_))); const float qs_ = am_ > 0.f ? 127.0f * __builtin_amdgcn_rcpf(am_) : 0.f; \
            s_[lane] = rr[0]; s_[64 + lane] = rr[1]; ((LAS signed char*)(s_ + 128))[lane] = (signed char)(int)__builtin_rintf(wa_ * qs_); ((LAS signed char*)(s_ + 128))[64 + lane] = (signed char)(int)__builtin_rintf(wb_ * qs_); \
            swv[slot_] = am_ * (1.0f / 127.0f); __builtin_amdgcn_fence(__ATOMIC_RELEASE, "wavefront"); __builtin_amdgcn_wave_barrier(); __builtin_amdgcn_fence(__ATOMIC_ACQUIRE, "wavefront"); \
            _Pragma("unroll") for (int j_ = 0; j_ < 4; ++j_) { const u32x4 a_ = *(const LAS u32x4*)(s_ + 16 * q8 + 4 * j_); \
                _Pragma("unroll") for (int q_ = 0; q_ < 4; ++q_) ss[4 * j_ + q_] = *(const u32x4*)(ups + (unsigned)(a_[q_] * 128 + c8 * 16)); } } while (0)
#define XU_MSTAGE(ss, slot_, k_) do { const LAS int* s_ = slots + (slot_) * 256; int ac_[16]; \
            _Pragma("unroll") for (int q_ = 0; q_ < 16; ++q_) ac_[q_] = 0; \
            const u32x4 qw_ = *(const LAS u32x4*)(s_ + 128 + 4 * q8); const float sw_ = swv[slot_]; \
            _Pragma("unroll") for (int j_ = 0; j_ < 4; ++j_) { \
                _Pragma("unroll") for (int q_ = 0; q_ < 4; ++q_) { const int r0_ = (int)ss[4 * j_][q_], r1_ = (int)ss[4 * j_ + 1][q_], r2_ = (int)ss[4 * j_ + 2][q_], r3_ = (int)ss[4 * j_ + 3][q_]; \
                    const int lo01_ = __builtin_amdgcn_perm(r1_, r0_, 0x05010400), hi01_ = __builtin_amdgcn_perm(r1_, r0_, 0x07030602), lo23_ = __builtin_amdgcn_perm(r3_, r2_, 0x05010400), hi23_ = __builtin_amdgcn_perm(r3_, r2_, 0x07030602); \
                    ac_[4 * q_ + 0] = __builtin_amdgcn_sdot4(__builtin_amdgcn_perm(lo23_, lo01_, 0x05040100), (int)qw_[j_], ac_[4 * q_ + 0], false); \
                    ac_[4 * q_ + 1] = __builtin_amdgcn_sdot4(__builtin_amdgcn_perm(lo23_, lo01_, 0x07060302), (int)qw_[j_], ac_[4 * q_ + 1], false); \
                    ac_[4 * q_ + 2] = __builtin_amdgcn_sdot4(__builtin_amdgcn_perm(hi23_, hi01_, 0x05040100), (int)qw_[j_], ac_[4 * q_ + 2], false); \
                    ac_[4 * q_ + 3] = __builtin_amdgcn_sdot4(__builtin_amdgcn_perm(hi23_, hi01_, 0x07060302), (int)qw_[j_], ac_[4 * q_ + 3], false); } } \
              \
            int k8_[8]; \
            _Pragma("unroll") for (int q_ = 0; q_ < 8; ++q_) { const u32x2 r_ = __builtin_amdgcn_permlane32_swap((unsigned)ac_[q_], (unsigned)ac_[8 + q_], false, false); k8_[q_] = (int)(r_.x + r_.y); } \
            int k4_[4]; \
            _Pragma("unroll") for (int q_ = 0; q_ < 4; ++q_) { const u32x2 r_ = __builtin_amdgcn_permlane16_swap((unsigned)k8_[q_], (unsigned)k8_[4 + q_], false, false); k4_[q_] = (int)(r_.x + r_.y); } \
            int k2_[2]; \
            _Pragma("unroll") for (int q_ = 0; q_ < 2; ++q_) { const int snd_ = b8 ? k4_[q_] : k4_[2 + q_], kp_ = b8 ? k4_[2 + q_] : k4_[q_]; k2_[q_] = kp_ + __builtin_amdgcn_update_dpp(0, snd_, 0x128, 0xF, 0xF, false); } \
            const f32x2 k1_ = (f32x2){(float)k2_[0] * sw_, (float)k2_[1] * sw_}; \
            const float sq_ = wave_sum(k1_.x * k1_.x + k1_.y * k1_.y); \
            if ((k_) < K) { const int tok_ = t0 + (k_) * tstride; const int col_ = sl * 128 + c8 * 16 + (b32 ? 8 : 0) + (b16 ? 4 : 0) + (b8 ? 2 : 0); \
                *(unsigned*)(fbuf + (size_t)tok_ * DM + col_) = cvt_pk_bf16(k1_.x, k1_.y); if (lane == 0) ssq[(size_t)tok_ * 8 + sl] = sq_; } } while (0)
        XU_RAW(rawA, 0);
        XU_LSTAGE(seg0, rawA, 0);
        XU_RAW(rawA, 1); XU_RAW(rawB, 2);
#pragma unroll 1
        for (int k = 0; k < K; k += 2) {
            XU_LSTAGE(seg1, rawA, 1);
            XU_RAW(rawA, k + 3);
            XU_MSTAGE(seg0, 0, k);
            XU_LSTAGE(seg0, rawB, 0);
            XU_RAW(rawB, k + 4);
            XU_MSTAGE(seg1, 1, k + 1);
        }
#undef XU_TOK
#undef XU_RAW
#undef XU_LSTAGE
#undef XU_MSTAGE
    }
}

__device__ __forceinline__ void phase_final(const Params& p, const int tid0) {
    const int lane = tid0 & 63, w = tid0 >> 6;
    const bf16_t* fbuf = (const bf16_t*)(p.ws + WS_F); const float* ssq = (const float*)(p.ws + WS_SSQ); const float* mod = (const float*)(p.ws + WS_MOD);
    const int stride = gridDim.x * 8;
    const bf16_t* x1b = (const bf16_t*)(p.ws + WS_X1B);
    u32x2 fq[4], fqn[4]; u32x2 x1[4], x1n[4]; f32x4 sq[2], sqn[2]; f32x4 pC[4]; int curb = -1;
#define PF_LOAD(fd, xd, sd, r_) do { const int rr_ = (r_) < T ? (r_) : T - 1; _Pragma("unroll") for (int i_ = 0; i_ < 4; ++i_) { fd[i_] = __builtin_nontemporal_load((const u32x2*)(fbuf + (size_t)rr_ * DM + i_ * 256 + lane * 4)); xd[i_] = __builtin_nontemporal_load((const u32x2*)(x1b + (size_t)rr_ * DM + i_ * 256 + lane * 4)); } \
        sd[0] = *(const f32x4*)(ssq + (size_t)rr_ * 8); sd[1] = *(const f32x4*)(ssq + (size_t)rr_ * 8 + 4); } while (0)
    PF_LOAD(fq, x1, sq, blockIdx.x * 8 + w);
    for (int tok = blockIdx.x * 8 + w; tok < T; tok += stride) {
        PF_LOAD(fqn, x1n, sqn, tok + stride);
        const int b = tok / SEQ;
        if (b != curb) {
            curb = b;
#pragma unroll
            for (int i = 0; i < 4; ++i) { const int c = i * 256 + lane * 4; const f32x4 g = *(const f32x4*)(p.g_post_ffn + c), gt2 = *(const f32x4*)(mod + b * 6144 + 5120 + c);
#pragma unroll
                for (int j = 0; j < 4; ++j) pC[i][j] = g[j] * gt2[j]; }
        }
        const float ss = (sq[0][0] + sq[0][1]) + (sq[0][2] + sq[0][3]) + (sq[1][0] + sq[1][1]) + (sq[1][2] + sq[1][3]);
        const float rstd = rsqrtf(ss * (1.0f / DM) + NORM_EPS);
#pragma unroll
        for (int i = 0; i < 4; ++i) { const int c = i * 256 + lane * 4; float* op = p.out + (size_t)tok * DM + c;
            const f32x4 fv = (f32x4){bf_lo(fq[i].x), bf_hi(fq[i].x), bf_lo(fq[i].y), bf_hi(fq[i].y)}, xv = (f32x4){bf_lo(x1[i].x), bf_hi(x1[i].x), bf_lo(x1[i].y), bf_hi(x1[i].y)};
            f32x4 o;
#pragma unroll
            for (int j = 0; j < 4; ++j) o[j] = xv[j] + pC[i][j] * (fv[j] * rstd);
            *(f32x4*)op = o; }
#pragma unroll
        for (int i = 0; i < 4; ++i) { fq[i] = fqn[i]; x1[i] = x1n[i]; }
        sq[0] = sqn[0]; sq[1] = sqn[1];
    }
#undef PF_LOAD
}

#define XB_TMO      128
#define XB_XCNT(j)  (256  + 64 * (j))
#define XB_XSUB(j)  (1280 + 64 * (j))
#define XB_XGEN(j)  (2304 + 64 * (j))
#define XB_TOP      3328
#define XB_TOPGEN   3392
#define XCD_BAR_WORDS 3456
#define XB_SPIN_CAP (1u << 18)

__device__ __forceinline__ unsigned xb_ld(unsigned* p)              { return __hip_atomic_load(p, __ATOMIC_RELAXED, __HIP_MEMORY_SCOPE_AGENT); }
__device__ __forceinline__ unsigned xb_add(unsigned* p, unsigned v) { return __hip_atomic_fetch_add(p, v, __ATOMIC_RELAXED, __HIP_MEMORY_SCOPE_AGENT); }
__device__ __forceinline__ unsigned xb_xcc_id() { return (unsigned)__builtin_amdgcn_s_getreg((3 << 11) | 20) & 0xFu; }
#define XB_SPIN(cond, bar) do { unsigned _sp = 0; while (cond) { __builtin_amdgcn_s_sleep(1); \
    if ((++_sp & 255u) == 0u) { if (xb_ld(&(bar)[XB_TMO])) break; if (_sp > XB_SPIN_CAP) { atomicAdd(&(bar)[XB_TMO], 1u); break; } } } } while (0)

struct XcdBarrier {
    unsigned* bar; unsigned x;
    volatile LAS unsigned* st;
};

__device__ __forceinline__ XcdBarrier xcd_barrier_post(unsigned* bar, volatile LAS unsigned* st) {
    XcdBarrier b; b.bar = bar; b.x = xb_xcc_id(); b.st = st;
    if (threadIdx.x == 0) (void)xb_add(&bar[XB_XCNT(b.x)], 1u);
    return b;
}
__device__ __forceinline__ void xcd_barrier_complete(unsigned* bar, unsigned x, unsigned& nloc, unsigned& nx) {
    const unsigned G = gridDim.x * gridDim.y * gridDim.z;
    unsigned sum, cnt, mine, sp = 0u;
    for (;;) {
        sum = 0u; cnt = 0u; mine = 0u;
#pragma unroll
        for (unsigned j = 0; j < 16; ++j) { const unsigned c = xb_ld(&bar[XB_XCNT(j)]); sum += c; cnt += (c > 0u) ? 1u : 0u; mine = (j == x) ? c : mine; }
        if (sum == G) break;
        __builtin_amdgcn_s_sleep(1);
        if ((++sp & 255u) == 0u) { if (xb_ld(&bar[XB_TMO])) break; if (sp > XB_SPIN_CAP) { atomicAdd(&bar[XB_TMO], 1u); break; } }
    }
    nloc = mine > 0u ? mine : 1u; nx = cnt > 0u ? cnt : 1u;
}

__device__ __forceinline__ void xcd_barrier(const XcdBarrier& b) {
    asm volatile("s_waitcnt vmcnt(0)" ::: "memory");
    __syncthreads();
    if (threadIdx.x == 0) {
        unsigned* bar = b.bar;
        __builtin_amdgcn_s_waitcnt(0);
        unsigned nloc = b.st[0], nx = b.st[1];
        if (nloc == 0u) { xcd_barrier_complete(bar, b.x, nloc, nx); b.st[0] = nloc; b.st[1] = nx; }
        const unsigned old = xb_add(&bar[XB_XSUB(b.x)], 1u);
        const unsigned gen = old / nloc;
        if (old + 1u == (gen + 1u) * nloc) {
            __builtin_amdgcn_fence(__ATOMIC_RELEASE, "agent");
            asm volatile("s_waitcnt vmcnt(0)" ::: "memory");
            const unsigned og = xb_add(&bar[XB_TOP], 1u);
            const unsigned tg = og / nx;
            if (og + 1u == (tg + 1u) * nx) xb_add(&bar[XB_TOPGEN], 1u);
            else XB_SPIN(xb_ld(&bar[XB_TOPGEN]) == tg, bar);
            __builtin_amdgcn_fence(__ATOMIC_ACQUIRE, "agent");
            xb_add(&bar[XB_XGEN(b.x)], 1u);
            asm volatile("s_waitcnt vmcnt(0)" ::: "memory");
        } else {
            XB_SPIN(xb_ld(&bar[XB_XGEN(b.x)]) == gen, bar);
            __builtin_amdgcn_fence(__ATOMIC_ACQUIRE, "agent");
            asm volatile("s_waitcnt vmcnt(0)" ::: "memory");
        }
    }
    __syncthreads();
}


constexpr int NPH = 17;
#ifndef PROBE_MASK
#define PROBE_MASK 0
#endif
__device__ __forceinline__ void run_gemm(LAS unsigned char* lds, const bf16_t* A, const bf16_t* Bt, int N, int K, int kind, unsigned char* ws, unsigned char* dout) {
    pg8::Gemm g{A, Bt, T, N, K}; EpiGen E{kind, ws, dout}; pg8::StaticOrder S; S.init(g.M, g.N, __builtin_amdgcn_readfirstlane((int)gridDim.x), __builtin_amdgcn_readfirstlane((int)blockIdx.x)); pg8::gemm_phase<EpiGen, pg8::StaticOrder>(lds, g, S, E);
}
#define XB_RANK(j) (XCD_BAR_WORDS + 64 * (j))
constexpr int CTL_WORDS = XCD_BAR_WORDS + 64 * 16;
__device__ __forceinline__ SliceInfo slice_info(const Params& p, const XcdBarrier& xb, volatile LAS unsigned* xst) {
    unsigned* bar = (unsigned*)(p.ws + WS_CTL);
    if (threadIdx.x == 0) { unsigned below = 0u;
        for (unsigned j = 0; j < 16; ++j) { const unsigned c = xb_ld(&bar[XB_XCNT(j)]); if (c > 0u && j < xb.x) ++below; }
        xst[3] = below; }
    __syncthreads();
    SliceInfo si; si.nloc = (int)xst[0]; si.nx = (int)xst[1]; si.rank = (int)xst[2]; si.sidx = (int)xst[3];
    if (si.nloc < 1) si.nloc = 1; if (si.nx < 1) si.nx = 1; if (si.rank >= si.nloc) si.rank = si.rank % si.nloc; if (si.sidx >= si.nx) si.sidx = si.sidx % si.nx;
    return si;
}
__global__ void __launch_bounds__(512, 2) fwd_kernel(Params p) {
    extern __shared__ __attribute__((aligned(16))) unsigned char shm[];
    LAS unsigned char* lds = (LAS unsigned char*)shm;
    volatile LAS unsigned* xst = (volatile LAS unsigned*)(lds + LDS_MAIN);
    if (threadIdx.x == 0) { xst[0] = 0u; xst[1] = 0u; xst[2] = 0u; xst[3] = 0u; }
    __syncthreads();
    const XcdBarrier xb = xcd_barrier_post((unsigned*)(p.ws + WS_CTL), xst);
    if (threadIdx.x == 0) xst[2] = xb_add((unsigned*)(p.ws + WS_CTL) + XB_RANK(xb.x), 1u);
    const int lo = (int)p.ph_lo, hi = (int)p.ph_hi;
    unsigned char* const dout = (unsigned char*)p.out;
#if PROBE_MASK
#define PHASE(k, body) if (lo <= (k) && (k) < hi) { { const int tid0 = threadIdx.x; body; } if ((PROBE_MASK >> (k)) & 1) { xcd_barrier(xb); int tid0 = threadIdx.x; asm volatile("" : "+v"(tid0)); body; } if ((k) + 1 < hi) xcd_barrier(xb); }
#else
#define PHASE(k, body) if (lo <= (k) && (k) < hi) { const int tid0 = threadIdx.x; body; if ((k) + 1 < hi) xcd_barrier(xb); }
#endif
    PHASE(0, phase_prep(p, lds, tid0))
    PHASE(1, phase_h(p, tid0))
    PHASE(2, run_gemm(lds, (const bf16_t*)(dout + DO_H), (const bf16_t*)(p.ws + WS_WIN_T), NA, 1024, EK_A, p.ws, dout))
    PHASE(3, phase_attn(p, lds, tid0))
    PHASE(4, phase_combine(p, tid0); __syncthreads(); run_gemm(lds, (const bf16_t*)(dout + DO_H), (const bf16_t*)(p.ws + WS_WIN_T) + (size_t)NA * 1024, NBC, 1024, EK_B, p.ws, dout))
    PHASE(5, phase_kv(p, lds, tid0))
    PHASE(6, phase_scan(p, tid0))
    PHASE(7, phase_ret(p, lds, tid0))
    PHASE(8, run_gemm(lds, (const bf16_t*)(dout + DO_YATT), (const bf16_t*)(p.ws + WS_WA_T), 1024, 512, EK_C, p.ws, dout); __syncthreads();
             run_gemm(lds, (const bf16_t*)(p.ws + WS_RO), (const bf16_t*)(p.ws + WS_WR_T), 1024, 1024, EK_D, p.ws, dout))
    PHASE(10, run_gemm(lds, (const bf16_t*)(p.ws + WS_Y), (const bf16_t*)(p.ws + WS_WMX_T), 1024, 1024, EK_E, p.ws, dout))
    PHASE(11, phase_rows(p, tid0))
    PHASE(12, run_gemm(lds, (const bf16_t*)(p.ws + WS_H2), (const bf16_t*)(p.ws + WS_WPQ_T), 2048, 1024, EK_F, p.ws, dout))
    PHASE(13, phase_route(p, lds, tid0))
#ifdef XDN_PROBE
    PHASE(14, phase_xdown<XDN_PROBE>(p, lds, tid0, slice_info(p, xb, xst)); xcd_barrier(xb); phase_xdown<0>(p, lds, tid0, slice_info(p, xb, xst)))
#else
    PHASE(14, phase_xdown<0>(p, lds, tid0, slice_info(p, xb, xst)))
#endif
    PHASE(15, phase_xup(p, lds, tid0, slice_info(p, xb, xst)))
    PHASE(16, phase_final(p, tid0))
#undef PHASE
}

extern "C" void kernel_launch(void* const* d_in, const int* in_sizes, int n_in, void* d_out, int out_size, void* d_ws, size_t ws_size, hipStream_t stream) {
    static int grid_blocks = 0;
    if (grid_blocks == 0) {
        if (n_in != 18 || ws_size < WS_END) { fprintf(stderr, "kernel_launch: unexpected n_in %d / ws_size %zu\n", n_in, ws_size); grid_blocks = -1; return; }
        int dev = 0, cus = 0, per_cu = 0;
        hipGetDevice(&dev); hipDeviceGetAttribute(&cus, hipDeviceAttributeMultiprocessorCount, dev);
        if (hipFuncSetAttribute((const void*)fwd_kernel, hipFuncAttributeMaxDynamicSharedMemorySize, LDS_BYTES) != hipSuccess) { fprintf(stderr, "kernel_launch: hipFuncSetAttribute failed\n"); grid_blocks = -1; return; }
        hipOccupancyMaxActiveBlocksPerMultiprocessor(&per_cu, (const void*)fwd_kernel, 512, LDS_BYTES);
        if (per_cu < 1) { fprintf(stderr, "kernel_launch: occupancy query says %d blocks per CU\n", per_cu); per_cu = 1; }
        grid_blocks = cus;
        (void)hipGetLastError();
    }
    if (grid_blocks < 0) return;
    if (hipMemsetAsync((unsigned char*)d_ws + WS_CTL, 0, CTL_WORDS * sizeof(unsigned), stream) != hipSuccess) { fprintf(stderr, "kernel_launch: hipMemsetAsync failed\n"); return; }
    Params p{};
    p.x = (const float*)d_in[0]; p.c = (const float*)d_in[1]; p.pos = (const int*)d_in[2]; p.w_ada = (const float*)d_in[3]; p.b_ada = (const float*)d_in[4];
    p.g_pre_mix = (const float*)d_in[5]; p.g_post_mix = (const float*)d_in[6]; p.w_in = (const float*)d_in[7]; p.w_att = (const float*)d_in[8]; p.w_ret = (const float*)d_in[9];
    p.w_mix = (const float*)d_in[10]; p.g_pre_ffn = (const float*)d_in[11]; p.g_post_ffn = (const float*)d_in[12]; p.w_pq = (const float*)d_in[13]; p.keys1 = (const float*)d_in[14];
    p.keys2 = (const float*)d_in[15]; p.down = (const float*)d_in[16]; p.up = (const float*)d_in[17]; p.out = (float*)d_out; p.ws = (unsigned char*)d_ws;
#if defined(MULTI_LAUNCH)
    for (int ph = 0; ph < NPH; ++ph) { p.ph_lo = ph; p.ph_hi = ph + 1; hipLaunchKernelGGL(fwd_kernel, dim3(grid_blocks), dim3(512), LDS_BYTES, stream, p); }
#else
    p.ph_lo = 0; p.ph_hi = NPH; p.rep_mask = PROBE_MASK;
    void* args[] = {&p};
    hipError_t e = hipLaunchCooperativeKernel((const void*)fwd_kernel, dim3(grid_blocks), dim3(512), args, LDS_BYTES, stream);
    if (e != hipSuccess) fprintf(stderr, "cooperative launch failed: %s (grid %d)\n", hipGetErrorString(e), grid_blocks);
#endif
}
```
